# Optimizing an MI355X kernel written in HIP

```python
import math
import jax, jax.numpy as jnp
from jax import lax
import numpy as np

D_MODEL = 1024
BATCH = 16
SEQ = 4096
DEPTH = 2

GRID_W = 64
HEAD_DIM = D_MODEL // 16
GROUP_W = 4 * HEAD_DIM
MIX_WIDTH = 4 * GROUP_W
N_HEADS_A = 4
N_KV_A = 2
GQA_GROUP = N_HEADS_A // N_KV_A
N_HEADS_B = 4
MLA_Q_RANK = 3 * HEAD_DIM
MLA_KV_RANK = 2 * HEAD_DIM
MLA_NOPE = HEAD_DIM
MLA_ROPE = HEAD_DIM // 2
MLA_V = HEAD_DIM
N_HEADS_C = 4
DIFF_QK = HEAD_DIM // 2
DIFF_V = HEAD_DIM
N_HEADS_D = 4
NA_ROWS_MAX = 8
NA_COLS = 16
D_FF = 4 * D_MODEL
Q_BLOCK = 128
ROPE_BASE = 10000.0
EPS = 1e-6

A_COLS = (N_HEADS_A + 2 * N_KV_A) * HEAD_DIM
B_COLS = MLA_Q_RANK + MLA_KV_RANK + MLA_ROPE
C_COLS = 3 * GROUP_W
D_COLS = 3 * GROUP_W
IN_COLS = A_COLS + B_COLS + C_COLS + D_COLS
SPLITS = (A_COLS, A_COLS + B_COLS, A_COLS + B_COLS + C_COLS)

kernel_name = 'hybrid_parallel_heads_encoder'


def rms_norm(x, g):
    xf = x.astype(jnp.float32)
    y = xf * lax.rsqrt(jnp.mean(xf * xf, axis=-1, keepdims=True) + EPS)
    return (y * g.astype(jnp.float32)).astype(x.dtype)


def rope_angles(pos, dim):
    inv = ROPE_BASE ** (-jnp.arange(0, dim, 2, dtype=jnp.float32) / dim)
    return pos.astype(jnp.float32)[:, None] * inv[None, :]


def apply_rope(x, ang):
    x1, x2 = jnp.split(x, 2, axis=-1)
    cos = jnp.cos(ang).astype(x.dtype)
    sin = jnp.sin(ang).astype(x.dtype)
    return jnp.concatenate([x1 * cos - x2 * sin, x1 * sin + x2 * cos], axis=-1)


def axial_rope(x, ang_row, ang_col):
    xr, xc = jnp.split(x, 2, axis=-1)
    return jnp.concatenate([apply_rope(xr, ang_row), apply_rope(xc, ang_col)], axis=-1)


def alibi_slopes(n_heads):
    return jnp.exp2(-8.0 * jnp.arange(1, n_heads + 1, dtype=jnp.float32) / n_heads)


def neighbourhood_index(n_tokens):
    rows = n_tokens // GRID_W
    kr = min(NA_ROWS_MAX, rows)
    kc = min(NA_COLS, GRID_W)
    t = jnp.arange(n_tokens, dtype=jnp.int32)
    r, c = t // GRID_W, t % GRID_W
    r0 = jnp.clip(r - kr // 2, 0, rows - kr)
    c0 = jnp.clip(c - kc // 2, 0, GRID_W - kc)
    key_r = r0[:, None, None] + jnp.arange(kr, dtype=jnp.int32)[None, :, None]
    key_c = c0[:, None, None] + jnp.arange(kc, dtype=jnp.int32)[None, None, :]
    idx = (key_r * GRID_W + key_c).reshape(n_tokens, kr * kc)
    dr = key_r - r[:, None, None] + (NA_ROWS_MAX - 1)
    dc = key_c - c[:, None, None] + (NA_COLS - 1)
    rel = (dr * (2 * NA_COLS - 1) + dc).reshape(n_tokens, kr * kc)
    return idx, rel


def sweep_query_blocks(block_fn, n_tokens):
    out = lax.map(block_fn, jnp.arange(n_tokens // Q_BLOCK))
    return jnp.moveaxis(out, 0, 1).reshape(out.shape[1], n_tokens, out.shape[-1])


def gqa_axial(u, q_gain, k_gain, ang_row, ang_col):
    b, s, _ = u.shape
    q, k, v = jnp.split(u, [N_HEADS_A * HEAD_DIM, (N_HEADS_A + N_KV_A) * HEAD_DIM], axis=-1)
    q = q.reshape(b, s, N_KV_A, GQA_GROUP, HEAD_DIM).transpose(0, 2, 3, 1, 4)
    k = k.reshape(b, s, N_KV_A, HEAD_DIM).transpose(0, 2, 1, 3)
    v = v.reshape(b, s, N_KV_A, HEAD_DIM).transpose(0, 2, 1, 3)
    q = axial_rope(rms_norm(q, q_gain), ang_row, ang_col)
    k = axial_rope(rms_norm(k, k_gain), ang_row, ang_col)
    scale = HEAD_DIM ** -0.5

    def block(i):
        qb = lax.dynamic_slice_in_dim(q, i * Q_BLOCK, Q_BLOCK, axis=3)
        sc = jnp.einsum('bkgqd,bksd->bkgqs', qb, k, preferred_element_type=jnp.float32) * scale
        p = jax.nn.softmax(sc, axis=-1).astype(v.dtype)
        o = jnp.einsum('bkgqs,bksd->bqkgd', p, v)
        return o.reshape(b, Q_BLOCK, N_HEADS_A * HEAD_DIM)

    return sweep_query_blocks(block, s)


def mla(u, cq_gain, ckv_gain, w_uq, w_ukv, ang_seq):
    b, s, _ = u.shape
    c_q, c_kv, k_rope = jnp.split(u, [MLA_Q_RANK, MLA_Q_RANK + MLA_KV_RANK], axis=-1)
    q = (rms_norm(c_q, cq_gain) @ w_uq).reshape(b, s, N_HEADS_B, MLA_NOPE + MLA_ROPE).transpose(0, 2, 1, 3)
    kv = (rms_norm(c_kv, ckv_gain) @ w_ukv).reshape(b, s, N_HEADS_B, MLA_NOPE + MLA_V).transpose(0, 2, 1, 3)
    q_nope, q_rope = jnp.split(q, [MLA_NOPE], axis=-1)
    k_nope, v = jnp.split(kv, [MLA_NOPE], axis=-1)
    q_rope = apply_rope(q_rope, ang_seq)
    k_rope = apply_rope(k_rope, ang_seq)
    scale = (MLA_NOPE + MLA_ROPE) ** -0.5

    def block(i):
        qn = lax.dynamic_slice_in_dim(q_nope, i * Q_BLOCK, Q_BLOCK, axis=2)
        qr = lax.dynamic_slice_in_dim(q_rope, i * Q_BLOCK, Q_BLOCK, axis=2)
        sc = (jnp.einsum('bhqd,bhsd->bhqs', qn, k_nope, preferred_element_type=jnp.float32)
              + jnp.einsum('bhqr,bsr->bhqs', qr, k_rope, preferred_element_type=jnp.float32)) * scale
        p = jax.nn.softmax(sc, axis=-1).astype(v.dtype)
        o = jnp.einsum('bhqs,bhsd->bqhd', p, v)
        return o.reshape(b, Q_BLOCK, N_HEADS_B * MLA_V)

    return sweep_query_blocks(block, s)


def diff_attention(u, lq1, lk1, lq2, lk2, g_head, slopes, lambda_init):
    b, s, _ = u.shape
    q, k, v = jnp.split(u, [GROUP_W, 2 * GROUP_W], axis=-1)
    q = q.reshape(b, s, N_HEADS_C, 2, DIFF_QK).transpose(0, 2, 3, 1, 4)
    k = k.reshape(b, s, N_HEADS_C, 2, DIFF_QK).transpose(0, 2, 3, 1, 4)
    v = v.reshape(b, s, N_HEADS_C, DIFF_V).transpose(0, 2, 1, 3)
    f32 = jnp.float32
    lam = (jnp.exp(jnp.sum(lq1.astype(f32) * lk1.astype(f32)))
           - jnp.exp(jnp.sum(lq2.astype(f32) * lk2.astype(f32))) + lambda_init)
    t = jnp.arange(s, dtype=jnp.int32)
    scale = DIFF_QK ** -0.5

    def block(i):
        qb = lax.dynamic_slice_in_dim(q, i * Q_BLOCK, Q_BLOCK, axis=3)
        qpos = i * Q_BLOCK + jnp.arange(Q_BLOCK, dtype=jnp.int32)
        dist = jnp.abs(qpos[:, None] - t[None, :]).astype(f32)
        bias = -slopes[:, None, None, None] * dist
        sc = jnp.einsum('bhmqd,bhmsd->bhmqs', qb, k, preferred_element_type=f32) * scale + bias
        p = jax.nn.softmax(sc, axis=-1)
        a = (p[:, :, 0] - lam * p[:, :, 1]).astype(v.dtype)
        o = jnp.einsum('bhqs,bhsd->bqhd', a, v)
        o = rms_norm(o, g_head) * (1.0 - lambda_init)
        return o.reshape(b, Q_BLOCK, N_HEADS_C * DIFF_V)

    return sweep_query_blocks(block, s)


def neighbourhood_attention(u, rel_bias, na_idx, na_rel):
    b, s, _ = u.shape
    q, k, v = jnp.split(u, [GROUP_W, 2 * GROUP_W], axis=-1)
    q = q.reshape(b, s, N_HEADS_D, HEAD_DIM)
    k = k.reshape(b, s, N_HEADS_D, HEAD_DIM)
    v = v.reshape(b, s, N_HEADS_D, HEAD_DIM)
    bias_flat = rel_bias.reshape(N_HEADS_D, -1).astype(jnp.float32)
    scale = HEAD_DIM ** -0.5

    def block(i):
        qb = lax.dynamic_slice_in_dim(q, i * Q_BLOCK, Q_BLOCK, axis=1)
        idx = lax.dynamic_slice_in_dim(na_idx, i * Q_BLOCK, Q_BLOCK, axis=0)
        rel = lax.dynamic_slice_in_dim(na_rel, i * Q_BLOCK, Q_BLOCK, axis=0)
        kb = jnp.take(k, idx, axis=1)
        vb = jnp.take(v, idx, axis=1)
        sc = (jnp.einsum('bqhd,bqnhd->bhqn', qb, kb, preferred_element_type=jnp.float32) * scale
              + jnp.take(bias_flat, rel, axis=1))
        p = jax.nn.softmax(sc, axis=-1).astype(v.dtype)
        o = jnp.einsum('bhqn,bqnhd->bqhd', p, vb)
        return o.reshape(b, Q_BLOCK, N_HEADS_D * HEAD_DIM)

    return sweep_query_blocks(block, s)


def setup_inputs(seed: int = 0) -> dict:
    key = jax.random.key(seed)
    ks = jax.random.split(key, 26)
    L = DEPTH

    def dense(k, fan_in, fan_out):
        return jax.random.normal(k, (L, fan_in, fan_out), jnp.float32) * fan_in ** -0.5

    def gain(k, dim):
        return 1.0 + 0.02 * jax.random.normal(k, (L, dim), jnp.float32)

    def small(k, shape, sc):
        return sc * jax.random.normal(k, shape, jnp.float32)

    return {
        'x': jax.random.normal(ks[0], (BATCH, SEQ, D_MODEL), jnp.float32),
        'norm_mix_pre': gain(ks[1], D_MODEL),
        'norm_mix_post': gain(ks[2], D_MODEL),
        'norm_mlp_pre': gain(ks[3], D_MODEL),
        'norm_mlp_post': gain(ks[4], D_MODEL),
        'w_in': dense(ks[5], D_MODEL, IN_COLS),
        'a_q_norm': gain(ks[6], HEAD_DIM),
        'a_k_norm': gain(ks[7], HEAD_DIM),
        'b_cq_norm': gain(ks[8], MLA_Q_RANK),
        'b_ckv_norm': gain(ks[9], MLA_KV_RANK),
        'b_w_uq': dense(ks[10], MLA_Q_RANK, N_HEADS_B * (MLA_NOPE + MLA_ROPE)),
        'b_w_ukv': dense(ks[11], MLA_KV_RANK, N_HEADS_B * (MLA_NOPE + MLA_V)),
        'c_lambda_q1': small(ks[12], (L, DIFF_QK), 0.1),
        'c_lambda_k1': small(ks[13], (L, DIFF_QK), 0.1),
        'c_lambda_q2': small(ks[14], (L, DIFF_QK), 0.1),
        'c_lambda_k2': small(ks[15], (L, DIFF_QK), 0.1),
        'd_rel_bias': small(ks[16], (L, N_HEADS_D, 2 * NA_ROWS_MAX - 1, 2 * NA_COLS - 1), 0.1),
        'g_out_a': gain(ks[17], GROUP_W),
        'g_out_b': gain(ks[18], GROUP_W),
        'g_out_c': gain(ks[19], DIFF_V),
        'g_out_d': gain(ks[20], GROUP_W),
        'w_out': dense(ks[21], MIX_WIDTH, D_MODEL),
        'w_up': dense(ks[22], D_MODEL, D_FF),
        'w_down': dense(ks[23], D_FF, D_MODEL),
    }


def reference(x, norm_mix_pre, norm_mix_post, norm_mlp_pre, norm_mlp_post, w_in,
              a_q_norm, a_k_norm, b_cq_norm, b_ckv_norm, b_w_uq, b_w_ukv,
              c_lambda_q1, c_lambda_k1, c_lambda_q2, c_lambda_k2, d_rel_bias,
              g_out_a, g_out_b, g_out_c, g_out_d, w_out, w_up, w_down):
    n_tokens = x.shape[1]
    t = jnp.arange(n_tokens, dtype=jnp.int32)
    ang_row = rope_angles(t // GRID_W, HEAD_DIM // 2)
    ang_col = rope_angles(t % GRID_W, HEAD_DIM // 2)
    ang_seq = rope_angles(t, MLA_ROPE)
    slopes = alibi_slopes(N_HEADS_C)
    na_idx, na_rel = neighbourhood_index(n_tokens)

    for l in range(DEPTH):
        h = rms_norm(x, norm_mix_pre[l])
        u = h @ w_in[l]
        ua, ub, uc, ud = jnp.split(u, SPLITS, axis=-1)
        oa = rms_norm(gqa_axial(ua, a_q_norm[l], a_k_norm[l], ang_row, ang_col), g_out_a[l])
        ob = rms_norm(mla(ub, b_cq_norm[l], b_ckv_norm[l], b_w_uq[l], b_w_ukv[l], ang_seq), g_out_b[l])
        lambda_init = 0.8 - 0.6 * math.exp(-0.3 * l)
        oc = diff_attention(uc, c_lambda_q1[l], c_lambda_k1[l], c_lambda_q2[l], c_lambda_k2[l],
                            g_out_c[l], slopes, lambda_init)
        od = rms_norm(neighbourhood_attention(ud, d_rel_bias[l], na_idx, na_rel), g_out_d[l])
        mix = jnp.concatenate([oa, ob, oc, od], axis=-1) @ w_out[l]
        x = x + rms_norm(mix, norm_mix_post[l])
        h = rms_norm(x, norm_mlp_pre[l])
        f = jnp.square(jax.nn.relu(h @ w_up[l])) @ w_down[l]
        x = x + rms_norm(f, norm_mlp_post[l])
    return x
```

```cpp
#include <hip/hip_runtime.h>
#include <hip/hip_cooperative_groups.h>
#include <cstdio>
namespace cg = cooperative_groups;

#ifndef MK_ONE_LAUNCH
#define MK_ONE_LAUNCH 1
#endif

typedef unsigned short bf16_t;
typedef __attribute__((ext_vector_type(8))) short bf16x8;
typedef __attribute__((ext_vector_type(16))) float f32x16;
typedef __attribute__((ext_vector_type(2))) float f32x2;
typedef __attribute__((ext_vector_type(2))) __bf16 bf16x2_t;
#define DI __device__ __forceinline__
#define MFMA(a, b, c) __builtin_amdgcn_mfma_f32_32x32x16_bf16((a), (b), (c), 0, 0, 0)

constexpr int NT = 512;
constexpr int T_TOK = 65536;
constexpr int SEQ = 4096;
constexpr float EPS = 1e-6f;
constexpr float LOG2E = 1.4426950408889634f;
constexpr long SLOT_ELEMS = (long)T_TOK * 64;

constexpr size_t OFF_CTRL = 0;
constexpr size_t OFF_KMAX = 1024;
constexpr size_t OFF_BAR  = 8192;
constexpr size_t OFF_ROPE = 8192 + 16384;
constexpr size_t OFF_WIN  = OFF_ROPE + 4096ull * 16 * 8;
constexpr size_t OFF_WUQ  = OFF_WIN + 2ull * 2560 * 1024 * 2;
constexpr size_t OFF_WUKV = OFF_WUQ + 2ull * 384 * 192 * 2;
constexpr size_t OFF_WOUT = OFF_WUKV + 2ull * 512 * 128 * 2;
constexpr size_t OFF_WUP  = OFF_WOUT + 2ull * 1024 * 1024 * 2;
constexpr size_t OFF_WDN  = OFF_WUP + 2ull * 4096 * 1024 * 2;
constexpr size_t OFF_ACT  = OFF_WDN + 2ull * 1024 * 4096 * 2;
constexpr size_t OFF_MIX  = OFF_ACT + (size_t)T_TOK * 1024 * 2;
constexpr size_t OFF_OCAT = OFF_MIX + (size_t)T_TOK * 1024 * 2;
constexpr size_t OFF_SSQ  = OFF_MIX + (size_t)T_TOK * 1024 * 4;
constexpr size_t OFF_RSTD = OFF_SSQ + (size_t)T_TOK * 8 * 4;
constexpr size_t OFF_BIG  = OFF_RSTD + (size_t)T_TOK * 4;
constexpr size_t WS_NEED  = OFF_BIG + (size_t)T_TOK * 4096 * 2;

constexpr int SL_AQ = 0, SL_AK = 4, SL_CQ = 6, SL_CK = 10, SL_DQ = 14, SL_DK = 18, SL_CQL = 22, SL_CKV = 25, SL_KR = 27;
constexpr int SL_AV = 28, SL_CV = 30, SL_DV = 34, SL_BQN = 38, SL_BQR = 42, SL_BKN = 44, SL_BV = 48;

constexpr int KM_A = 0, KM_C = 2, KM_D = 10, KM_BN = 14, KM_BR = 18;

struct Params {
  const float* in[24];
  float* out;
  unsigned char* ws;
};
enum { I_X = 0, I_NMIXPRE, I_NMIXPOST, I_NMLPPRE, I_NMLPPOST, I_WIN, I_AQN, I_AKN, I_BCQN, I_BCKVN, I_WUQ, I_WUKV,
       I_LQ1, I_LK1, I_LQ2, I_LK2, I_RELB, I_GA, I_GB, I_GC, I_GD, I_WOUT, I_WUP, I_WDN };

DI unsigned pk_bf16(float a, float b) {
  f32x2 f = {a, b};
  bf16x2_t v = __builtin_convertvector(f, bf16x2_t);
  return __builtin_bit_cast(unsigned, v);
}
DI float bf_lo(unsigned u) { return __uint_as_float(u << 16); }
DI float bf_hi(unsigned u) { return __uint_as_float(u & 0xffff0000u); }
DI float fexp2(float x) { return __builtin_amdgcn_exp2f(x); }
DI float frsq(float x) { return __builtin_amdgcn_rsqf(x); }
DI int crow(int i, int h) { return (i & 3) + 8 * (i >> 2) + 4 * h; }
DI float xhalf(float v) { return __shfl_xor(v, 32); }
DI void atomic_max_pos(unsigned* a, float v) { atomicMax(a, __float_as_uint(v)); }
DI int otid() { int t = threadIdx.x; asm volatile("" : "+v"(t)); return t; }

DI int win_src_col(int n) {
  const int j = n >> 6, c = n & 63;
  if (j < 4) return j * 64 + c;
  if (j < 6) return 256 + (j - 4) * 64 + c;
  if (j < 10) return 864 + (j - 6) * 64 + c;
  if (j < 14) return 1120 + (j - 10) * 64 + c;
  if (j < 18) return 1632 + (j - 14) * 64 + c;
  if (j < 22) return 1888 + (j - 18) * 64 + c;
  if (j < 25) return 512 + (j - 22) * 64 + c;
  if (j < 27) return 704 + (j - 25) * 64 + c;
  if (j == 27) return c < 32 ? 832 + c : -1;
  if (j < 30) return 384 + (j - 28) * 64 + c;
  if (j < 34) return 1376 + (j - 30) * 64 + c;
  if (j < 38) return 2144 + (j - 34) * 64 + c;
  return -1;
}
DI int wuq_src_col(int n) {
  const int j = n >> 6, c = n & 63;
  if (j < 4) return j * 96 + c;
  const int hh = (j - 4) * 2 + (c >> 5);
  return hh * 96 + 64 + (c & 31);
}
DI int wukv_src_col(int n) {
  const int j = n >> 6, c = n & 63;
  if (j < 4) return j * 128 + c;
  return (j - 4) * 128 + 64 + c;
}

template <int WID>
DI void convert_weight(const Params& p, int layer, float* tile  ) {
  constexpr int K = (WID == 0) ? 1024 : (WID == 1) ? 192 : (WID == 2) ? 128 : (WID == 3) ? 1024 : (WID == 4) ? 1024 : 4096;
  constexpr int NS = (WID == 0) ? 2400 : (WID == 1) ? 384 : (WID == 2) ? 512 : (WID == 3) ? 1024 : (WID == 4) ? 4096 : 1024;
  constexpr int ND = (WID == 0) ? 2560 : NS;
  constexpr int IIN = (WID == 0) ? I_WIN : (WID == 1) ? I_WUQ : (WID == 2) ? I_WUKV : (WID == 3) ? I_WOUT : (WID == 4) ? I_WUP : I_WDN;
  constexpr size_t OFF = (WID == 0) ? OFF_WIN : (WID == 1) ? OFF_WUQ : (WID == 2) ? OFF_WUKV : (WID == 3) ? OFF_WOUT : (WID == 4) ? OFF_WUP : OFF_WDN;
  const float* src = p.in[IIN] + (size_t)layer * K * NS;
  bf16_t* dst = (bf16_t*)(p.ws + OFF) + (size_t)layer * ND * K;
  constexpr int TK = K / 64, TN = ND / 64;
  const int tid = otid();
  for (int t = blockIdx.x; t < TK * TN; t += gridDim.x) {
    const int k0 = (t % TK) * 64, n0 = (t / TK) * 64;
    __syncthreads();
#pragma unroll
    for (int j = 0; j < 8; ++j) {
      const int kk = (tid >> 6) + 8 * j, nn = tid & 63;
      const int n = n0 + nn, k = k0 + kk;
      int sc;
      if (WID == 0) sc = win_src_col(n); else if (WID == 1) sc = wuq_src_col(n); else if (WID == 2) sc = wukv_src_col(n); else sc = n;
      float v = 0.f;
      if (sc >= 0) {
        v = src[(size_t)k * NS + sc];
        float g = 1.f;
        if (WID == 0) g = p.in[I_NMIXPRE][layer * 1024 + k];
        else if (WID == 1) g = p.in[I_BCQN][layer * 192 + k];
        else if (WID == 2) g = p.in[I_BCKVN][layer * 128 + k];
        else if (WID == 3) g = (k < 256) ? p.in[I_GA][layer * 256 + k] : (k < 512) ? p.in[I_GB][layer * 256 + k - 256] : (k < 768) ? 1.f : p.in[I_GD][layer * 256 + k - 768];
        else if (WID == 4) g = p.in[I_NMLPPRE][layer * 1024 + k];
        v *= g;
      }
      tile[kk * 65 + nn] = v;
    }
    __syncthreads();
#pragma unroll
    for (int j = 0; j < 4; ++j) {
      const int nn = (tid >> 5) + 16 * j, kk2 = (tid & 31) * 2;
      const unsigned u = pk_bf16(tile[kk2 * 65 + nn], tile[(kk2 + 1) * 65 + nn]);
      *(unsigned*)(dst + (size_t)(n0 + nn) * K + k0 + kk2) = u;
    }
  }
}

DI void phase_prep(const Params& p, char* smem) {
  const int tid = otid();
  if (blockIdx.x == 0 && tid < 16) atomicExch((unsigned*)(p.ws + OFF_CTRL) + tid, 0u);
  if (blockIdx.x == 2 && tid < 8) {
    const float* rb = p.in[I_RELB] + tid * 465;
    float mx = 0.f;
    for (int i = 0; i < 465; ++i) mx = fmaxf(mx, fabsf(rb[i]));
    ((float*)(p.ws + OFF_CTRL))[32 + tid] = mx * LOG2E;
  }
  if (blockIdx.x == 1) { atomicExch((unsigned*)(p.ws + OFF_KMAX) + tid, 0u); atomicExch((unsigned*)(p.ws + OFF_KMAX) + 512 + tid, 0u); }
  if (blockIdx.x == 0 && tid >= 64 && tid < 66) {
    const int l = tid - 64;
    float d1 = 0.f, d2 = 0.f;
    for (int i = 0; i < 32; ++i) {
      d1 += p.in[I_LQ1][l * 32 + i] * p.in[I_LK1][l * 32 + i];
      d2 += p.in[I_LQ2][l * 32 + i] * p.in[I_LK2][l * 32 + i];
    }
    const float li = 0.8f - 0.6f * expf(-0.3f * (float)l);
    float* c = (float*)(p.ws + OFF_CTRL);
    c[16 + 2 * l] = expf(d1) - expf(d2) + li;
    c[17 + 2 * l] = li;
  }
  {
    float2* tab = (float2*)(p.ws + OFF_ROPE);
    for (int e = blockIdx.x * NT + tid; e < 4096 * 16; e += gridDim.x * NT) {
      const int pos = e >> 4, f = e & 15;
      const float inv = powf(10000.f, -(float)(2 * f) / 32.f);
      const float ang = (float)pos * inv;
      double rev = (double)ang * 0.15915494309189535;
      rev -= floor(rev);
      const float rf = (float)rev;
      tab[e] = make_float2(__builtin_amdgcn_cosf(rf), __builtin_amdgcn_sinf(rf));
    }
  }
  float* tile = (float*)smem;
  for (int l = 0; l < 2; ++l) {
    convert_weight<0>(p, l, tile);
    convert_weight<1>(p, l, tile);
    convert_weight<2>(p, l, tile);
    convert_weight<3>(p, l, tile);
    convert_weight<4>(p, l, tile);
    convert_weight<5>(p, l, tile);
  }
}

DI float wave_sum(float v) {
#pragma unroll
  for (int o = 32; o; o >>= 1) v += __shfl_xor(v, o);
  return v;
}
DI void phase_resid(const float* x_f32, bf16_t* xb, const bf16_t* y, const float* g_post, float* out_f32, float* rstd_out, bool write_xb) {
  const int lane = otid() & 63;
  const int gw = blockIdx.x * (NT / 64) + (otid() >> 6), nw = gridDim.x * (NT / 64);
  for (int row = gw; row < T_TOK; row += nw) {
    float xv[2][8];
#pragma unroll
    for (int j = 0; j < 2; ++j) {
      const size_t off = (size_t)row * 1024 + j * 512 + lane * 8;
      if (x_f32) {
        const float4 a = *(const float4*)(x_f32 + off), c = *(const float4*)(x_f32 + off + 4);
        xv[j][0] = a.x; xv[j][1] = a.y; xv[j][2] = a.z; xv[j][3] = a.w; xv[j][4] = c.x; xv[j][5] = c.y; xv[j][6] = c.z; xv[j][7] = c.w;
      } else {
        const uint4 u = *(const uint4*)(xb + off);
        xv[j][0] = bf_lo(u.x); xv[j][1] = bf_hi(u.x); xv[j][2] = bf_lo(u.y); xv[j][3] = bf_hi(u.y);
        xv[j][4] = bf_lo(u.z); xv[j][5] = bf_hi(u.z); xv[j][6] = bf_lo(u.w); xv[j][7] = bf_hi(u.w);
      }
    }
    if (y) {
      float yv[2][8];
      float ss = 0.f;
#pragma unroll
      for (int j = 0; j < 2; ++j) {
        const uint4 u = *(const uint4*)(y + (size_t)row * 1024 + j * 512 + lane * 8);
        yv[j][0] = bf_lo(u.x); yv[j][1] = bf_hi(u.x); yv[j][2] = bf_lo(u.y); yv[j][3] = bf_hi(u.y);
        yv[j][4] = bf_lo(u.z); yv[j][5] = bf_hi(u.z); yv[j][6] = bf_lo(u.w); yv[j][7] = bf_hi(u.w);
#pragma unroll
        for (int e = 0; e < 8; ++e) ss += yv[j][e] * yv[j][e];
      }
      ss = wave_sum(ss);
      const float rs = frsq(ss * (1.f / 1024.f) + EPS);
#pragma unroll
      for (int j = 0; j < 2; ++j) {
        const float4 g0 = *(const float4*)(g_post + j * 512 + lane * 8), g1 = *(const float4*)(g_post + j * 512 + lane * 8 + 4);
        xv[j][0] += yv[j][0] * rs * g0.x; xv[j][1] += yv[j][1] * rs * g0.y; xv[j][2] += yv[j][2] * rs * g0.z; xv[j][3] += yv[j][3] * rs * g0.w;
        xv[j][4] += yv[j][4] * rs * g1.x; xv[j][5] += yv[j][5] * rs * g1.y; xv[j][6] += yv[j][6] * rs * g1.z; xv[j][7] += yv[j][7] * rs * g1.w;
      }
    }
    if (out_f32) {
#pragma unroll
      for (int j = 0; j < 2; ++j) {
        const size_t off = (size_t)row * 1024 + j * 512 + lane * 8;
        *(float4*)(out_f32 + off) = make_float4(xv[j][0], xv[j][1], xv[j][2], xv[j][3]);
        *(float4*)(out_f32 + off + 4) = make_float4(xv[j][4], xv[j][5], xv[j][6], xv[j][7]);
      }
    }
    if (write_xb) {
#pragma unroll
      for (int j = 0; j < 2; ++j) {
        uint4 u;
        u.x = pk_bf16(xv[j][0], xv[j][1]); u.y = pk_bf16(xv[j][2], xv[j][3]); u.z = pk_bf16(xv[j][4], xv[j][5]); u.w = pk_bf16(xv[j][6], xv[j][7]);
        *(uint4*)(xb + (size_t)row * 1024 + j * 512 + lane * 8) = u;
      }
    }
    if (rstd_out) {
      float ss = 0.f;
#pragma unroll
      for (int j = 0; j < 2; ++j)
#pragma unroll
        for (int e = 0; e < 8; ++e) ss += xv[j][e] * xv[j][e];
      ss = wave_sum(ss);
      if (lane == 0) rstd_out[row] = frsq(ss * (1.f / 1024.f) + EPS);
    }
  }
}

constexpr int G_ROW = 144;
constexpr int G_XS = 256 * G_ROW;
constexpr int G_STAGE = 384 * G_ROW;

template <bool SWAP>
DI void gemm_mainloop(const bf16_t* __restrict__ Xb, long x_slab, int ldx, const bf16_t* __restrict__ Wb, int K, char* smem,
                      f32x16 (&acc)[2][2]) {
  const int tid = otid(), lane = tid & 63, wave = tid >> 6, r = lane & 31, h = lane >> 5;
  const int wm = wave >> 1, wn = wave & 1;
  const int nkt = K >> 6;
  const int lrow = tid >> 3, lseg = tid & 7;
  const bf16_t* xg = Xb + (long)lrow * ldx + lseg * 8;
  const bf16_t* wg = Wb + (long)lrow * K + lseg * 8;
  const int lds_off = lrow * G_ROW + lseg * 16;
  uint4 xr[4], wr[2];
#pragma unroll
  for (int j = 0; j < 4; ++j) xr[j] = *(const uint4*)(xg + (long)j * 64 * ldx);
#pragma unroll
  for (int j = 0; j < 2; ++j) wr[j] = *(const uint4*)(wg + (long)j * 64 * K);
#pragma unroll
  for (int j = 0; j < 4; ++j) *(uint4*)(smem + lds_off + j * 64 * G_ROW) = xr[j];
#pragma unroll
  for (int j = 0; j < 2; ++j) *(uint4*)(smem + G_XS + lds_off + j * 64 * G_ROW) = wr[j];
  __syncthreads();
  const int xs_off = (wm * 64 + r) * G_ROW + h * 16;
  const int ws_off = G_XS + (wn * 64 + r) * G_ROW + h * 16;
  for (int kt = 0; kt < nkt; ++kt) {
    const char* cur = smem + (kt & 1) * G_STAGE;
    char* nxt = smem + ((kt + 1) & 1) * G_STAGE;
    const bool more = (kt + 1 < nkt);
    if (more) {
      const bf16_t* xg2 = xg + (long)(kt + 1) * x_slab;
      const bf16_t* wg2 = wg + (kt + 1) * 64;
#pragma unroll
      for (int j = 0; j < 4; ++j) xr[j] = *(const uint4*)(xg2 + (long)j * 64 * ldx);
#pragma unroll
      for (int j = 0; j < 2; ++j) wr[j] = *(const uint4*)(wg2 + (long)j * 64 * K);
    }
#pragma unroll
    for (int ks = 0; ks < 4; ++ks) {
      bf16x8 xf[2], wf[2];
      xf[0] = *(const bf16x8*)(cur + xs_off + ks * 32);
      xf[1] = *(const bf16x8*)(cur + xs_off + 32 * G_ROW + ks * 32);
      wf[0] = *(const bf16x8*)(cur + ws_off + ks * 32);
      wf[1] = *(const bf16x8*)(cur + ws_off + 32 * G_ROW + ks * 32);
#pragma unroll
      for (int nb = 0; nb < 2; ++nb)
#pragma unroll
        for (int tb = 0; tb < 2; ++tb) {
          if (SWAP) acc[nb][tb] = MFMA(wf[nb], xf[tb], acc[nb][tb]);
          else      acc[nb][tb] = MFMA(xf[tb], wf[nb], acc[nb][tb]);
        }
    }
    if (more) {
#pragma unroll
      for (int j = 0; j < 4; ++j) *(uint4*)(nxt + lds_off + j * 64 * G_ROW) = xr[j];
#pragma unroll
      for (int j = 0; j < 2; ++j) *(uint4*)(nxt + G_XS + lds_off + j * 64 * G_ROW) = wr[j];
    }
    __syncthreads();
  }
}

DI void epi_slot(f32x16 (&acc)[2][2], bf16_t* dst  , int tok0  , const float* norm_gain,
                 int rope, const float2* tab, float* ssq_out, const float (&rs)[2], unsigned* kmax_out = nullptr) {
  const int lane = otid() & 63, r = lane & 31, h = lane >> 5;
  float kmx = 0.f;
#pragma unroll
  for (int tb = 0; tb < 2; ++tb) {
    const int tok = tok0 + tb * 32 + r;
    float sc = rs[tb];
    if (norm_gain || ssq_out) {
      float ss = 0.f;
#pragma unroll
      for (int nb = 0; nb < 2; ++nb)
#pragma unroll
        for (int i = 0; i < 16; ++i) ss += acc[nb][tb][i] * acc[nb][tb][i];
      ss += xhalf(ss);
      if (ssq_out && h == 0) ssq_out[(size_t)tok * 8] = ss;
      if (norm_gain) {
        const float rstd = frsq(ss * (1.f / 64.f) + EPS);
#pragma unroll
        for (int nb = 0; nb < 2; ++nb)
#pragma unroll
          for (int i = 0; i < 16; ++i) acc[nb][tb][i] *= rstd * norm_gain[nb * 32 + crow(i, h)];
      }
    }
    if (rope) {
      const int s = tok & (SEQ - 1);
#pragma unroll
      for (int nb = 0; nb < 2; ++nb) {
        const int pos = (rope == 2) ? s : (nb == 0 ? (s >> 6) : (s & 63));
        const float2* tp = tab + pos * 16;
#pragma unroll
        for (int i = 0; i < 8; ++i) {
          const float2 cs = tp[crow(i, h)];
          const float x1 = acc[nb][tb][i], x2 = acc[nb][tb][i + 8];
          acc[nb][tb][i] = x1 * cs.x - x2 * cs.y;
          acc[nb][tb][i + 8] = x1 * cs.y + x2 * cs.x;
        }
      }
    }
#pragma unroll
    for (int nb = 0; nb < 2; ++nb)
#pragma unroll
      for (int g = 0; g < 4; ++g) {
        uint2 u;
        u.x = pk_bf16(acc[nb][tb][4 * g] * sc, acc[nb][tb][4 * g + 1] * sc);
        u.y = pk_bf16(acc[nb][tb][4 * g + 2] * sc, acc[nb][tb][4 * g + 3] * sc);
        *(uint2*)(dst + (size_t)tok * 64 + nb * 32 + 8 * g + 4 * h) = u;
      }
    if (kmax_out) {
      float ss = 0.f;
#pragma unroll
      for (int nb = 0; nb < 2; ++nb)
#pragma unroll
        for (int i = 0; i < 16; ++i) ss += acc[nb][tb][i] * acc[nb][tb][i];
      ss += xhalf(ss);
      kmx = fmaxf(kmx, ss * sc * sc);
    }
  }
  if (kmax_out) {
#pragma unroll
    for (int o = 1; o < 32; o <<= 1) kmx = fmaxf(kmx, __shfl_xor(kmx, o));
    if (lane == 0) atomic_max_pos(kmax_out, kmx);
  }
}

DI void epi_vt(f32x16 (&acc)[2][2], bf16_t* dst  , int tok0, const float* ssq) {
  const int lane = otid() & 63, r = lane & 31, h = lane >> 5;
  const int b = tok0 >> 12, s0 = tok0 & (SEQ - 1);
#pragma unroll
  for (int tb = 0; tb < 2; ++tb) {
    if (ssq) {
#pragma unroll
      for (int i = 0; i < 16; ++i) {
        const float* q = ssq + (size_t)(tok0 + tb * 32 + crow(i, h)) * 8;
        const float rstd = frsq((q[3] + q[4]) * (1.f / 128.f) + EPS);
        acc[0][tb][i] *= rstd;
        acc[1][tb][i] *= rstd;
      }
    }
#pragma unroll
    for (int nb = 0; nb < 2; ++nb)
#pragma unroll
      for (int g = 0; g < 4; ++g) {
        uint2 u;
        u.x = pk_bf16(acc[nb][tb][4 * g], acc[nb][tb][4 * g + 1]);
        u.y = pk_bf16(acc[nb][tb][4 * g + 2], acc[nb][tb][4 * g + 3]);
        *(uint2*)(dst + ((size_t)(b * 64 + nb * 32 + r)) * SEQ + s0 + tb * 32 + (g >> 1) * 16 + h * 8 + (g & 1) * 4) = u;
      }
  }
}

DI void zero_acc(f32x16 (&acc)[2][2]) {
#pragma unroll
  for (int a = 0; a < 2; ++a)
#pragma unroll
    for (int b = 0; b < 2; ++b)
#pragma unroll
      for (int i = 0; i < 16; ++i) acc[a][b][i] = 0.f;
}

enum { G_IN = 0, G_UQ, G_UKV, G_OUT, G_UP, G_DOWN };

template <int G>
DI void gemm_tile(const Params& p, int layer, int tile, char* smem) {
  constexpr int K = (G == G_IN) ? 1024 : (G == G_UQ) ? 192 : (G == G_UKV) ? 128 : (G == G_OUT) ? 1024 : (G == G_UP) ? 1024 : 4096;
  constexpr int NTL = (G == G_IN) ? 19 : (G == G_UQ) ? 3 : (G == G_UKV) ? 4 : (G == G_OUT) ? 8 : (G == G_UP) ? 32 : 8;
  constexpr size_t WOFF = (G == G_IN) ? OFF_WIN : (G == G_UQ) ? OFF_WUQ : (G == G_UKV) ? OFF_WUKV : (G == G_OUT) ? OFF_WOUT : (G == G_UP) ? OFF_WUP : OFF_WDN;
  const int nt = tile % NTL, mt = tile / NTL;
  const int m0 = mt * 256, n0 = nt * 128;
  const int lane = otid() & 63, wave = otid() >> 6, r = lane & 31, h = lane >> 5;
  const int wm = wave >> 1, wn = wave & 1;
  bf16_t* big = (bf16_t*)(p.ws + OFF_BIG);
  const bf16_t* W = (const bf16_t*)(p.ws + WOFF) + (size_t)layer * (NTL * 128) * K + (size_t)n0 * K;
  const bf16_t* X; long x_slab; int ldx;
  if (G == G_IN || G == G_OUT || G == G_UP) { X = (const bf16_t*)(p.ws + OFF_ACT) + (size_t)m0 * 1024; x_slab = 64; ldx = 1024; }
  else if (G == G_DOWN) { X = big + (size_t)m0 * 4096; x_slab = 64; ldx = 4096; }
  else if (G == G_UQ) { X = big + SL_CQL * SLOT_ELEMS + (size_t)m0 * 64; x_slab = SLOT_ELEMS; ldx = 64; }
  else { X = big + SL_CKV * SLOT_ELEMS + (size_t)m0 * 64; x_slab = SLOT_ELEMS; ldx = 64; }
  const bool vt_tile = (G == G_IN && nt >= 14) || (G == G_UKV && nt >= 2);
  f32x16 acc[2][2];
  zero_acc(acc);
  const int tok0 = m0 + wm * 64;
  const float2* tab = (const float2*)(p.ws + OFF_ROPE);
  float* ssq = (float*)(p.ws + OFF_SSQ);
  if (vt_tile) {
    gemm_mainloop<false>(X, x_slab, ldx, W, K, smem, acc);
    if (G == G_IN) {
      const int slot = nt * 2 + wn;
      epi_vt(acc, big + slot * SLOT_ELEMS, tok0, nullptr);
    } else {
      const int slot = SL_BV + (nt - 2) * 2 + wn;
      epi_vt(acc, big + slot * SLOT_ELEMS, tok0, ssq);
    }
    return;
  }
  gemm_mainloop<true>(X, x_slab, ldx, W, K, smem, acc);
  if (G == G_IN) {
    const int slot = nt * 2 + wn;
    float rs[2] = {1.f, 1.f};
    const float* gain = nullptr; int rope = 0; float* so = nullptr;
    if (slot < 4) { gain = p.in[I_AQN] + layer * 64; rope = 1; rs[0] = rs[1] = 0.125f * LOG2E; }
    else if (slot < 6) { gain = p.in[I_AKN] + layer * 64; rope = 1; }
    else if (slot < 10) { rs[0] = rs[1] = 0.17677669529663687f * LOG2E; }
    else if (slot < 14) { }
    else if (slot < 18) { rs[0] = rs[1] = 0.125f * LOG2E; }
    else if (slot < 22) { }
    else if (slot < 27) { so = ssq + (slot - 22); }
    else { rope = 2; }
    epi_slot(acc, big + slot * SLOT_ELEMS, tok0, gain, rope, tab, so, rs);
  } else if (G == G_UQ) {
    const int slot = (nt < 2) ? SL_BQN + nt * 2 + wn : SL_BQR + wn;
    float rs[2];
#pragma unroll
    for (int tb = 0; tb < 2; ++tb) {
      const float* q = ssq + (size_t)(tok0 + tb * 32 + r) * 8;
      rs[tb] = frsq((q[0] + q[1] + q[2]) * (1.f / 192.f) + EPS) * (0.10206207261596575f * LOG2E);
    }
    epi_slot(acc, big + slot * SLOT_ELEMS, tok0, nullptr, (nt < 2) ? 0 : 2, tab, nullptr, rs);
  } else if (G == G_UKV) {
    const int slot = SL_BKN + nt * 2 + wn;
    float rs[2];
#pragma unroll
    for (int tb = 0; tb < 2; ++tb) {
      const float* q = ssq + (size_t)(tok0 + tb * 32 + r) * 8;
      rs[tb] = frsq((q[3] + q[4]) * (1.f / 128.f) + EPS);
    }
    epi_slot(acc, big + slot * SLOT_ELEMS, tok0, nullptr, 0, tab, nullptr, rs,
             (unsigned*)(p.ws + OFF_KMAX) + (layer * 16 + (tok0 >> 12)) * 32 + KM_BN + nt * 2 + wn);
  } else if (G == G_OUT || G == G_DOWN) {
    float* out = (float*)(p.ws + OFF_MIX);
#pragma unroll
    for (int tb = 0; tb < 2; ++tb)
#pragma unroll
      for (int nb = 0; nb < 2; ++nb)
#pragma unroll
        for (int g = 0; g < 4; ++g) {
          float4 v = make_float4(acc[nb][tb][4 * g], acc[nb][tb][4 * g + 1], acc[nb][tb][4 * g + 2], acc[nb][tb][4 * g + 3]);
          *(float4*)(out + (size_t)(tok0 + tb * 32 + r) * 1024 + n0 + wn * 64 + nb * 32 + 8 * g + 4 * h) = v;
        }
  } else {
#pragma unroll
    for (int tb = 0; tb < 2; ++tb)
#pragma unroll
      for (int nb = 0; nb < 2; ++nb)
#pragma unroll
        for (int g = 0; g < 4; ++g) {
          float v0 = fmaxf(acc[nb][tb][4 * g], 0.f), v1 = fmaxf(acc[nb][tb][4 * g + 1], 0.f);
          float v2 = fmaxf(acc[nb][tb][4 * g + 2], 0.f), v3 = fmaxf(acc[nb][tb][4 * g + 3], 0.f);
          uint2 u;
          u.x = pk_bf16(v0 * v0, v1 * v1);
          u.y = pk_bf16(v2 * v2, v3 * v3);
          *(uint2*)(big + (size_t)(tok0 + tb * 32 + r) * 4096 + n0 + wn * 64 + nb * 32 + 8 * g + 4 * h) = u;
        }
  }
}


namespace pg8 {
#define PG8_LAS __attribute__((address_space(3)))
typedef float f32x4 __attribute__((ext_vector_type(4)));
typedef unsigned u32x4 __attribute__((ext_vector_type(4)));
constexpr int BM = 256, BK = 64, HALF = 128, HTB = HALF * BK * 2, STAGE_BYTES = 8 * HTB, NXCD = 8, WGM = 8;
DI int lds_byte(int r, int c) { const int st = (r >> 4) * 2 + (c >> 5), rr = r & 15, cc = c & 31, ob = rr * 64 + cc * 2; return st * 1024 + (ob ^ (((ob >> 9) & 1) << 5)); }
DI void stage_rc(int b, int& R, int& C) { const int st = b / 1024, sb = b % 1024, swz = sb ^ (((sb >> 9) & 1) << 5); R = (st >> 1) * 16 + swz / 64; C = (st & 1) * 32 + (swz % 64) / 2; }
DI int perm32(int rho) { const int n = rho >> 4, i = rho & 15; return 8 * (i >> 2) + 4 * n + (i & 3); }
struct Unit { int pm, pn; };
struct Gemm { const bf16_t* A; const bf16_t* Bt; int M, N, K; };
struct StaticOrder {
  int nM, nN, nwg, G, c, rev;
  DI void init(int M, int N, int G_, int c_, int rev_ = 0) { nM = M / BM; nN = N / BM; nwg = nM * nN; G = G_; c = c_; rev = rev_; }
  DI bool next(int i, Unit& u) const {
    const int cntu = (c < nwg) ? (nwg - c + G - 1) / G : 0;
    if (i >= cntu) return false;
    const long L = (long)(rev ? cntu - 1 - i : i) * G + c;
    int wgid = (int)L; { const int q = nwg / NXCD, r = nwg % NXCD, xcd = wgid % NXCD, off = wgid / NXCD; wgid = (xcd < r ? xcd * (q + 1) : r * (q + 1) + (xcd - r) * q) + off; }
    const int nig = WGM * nN, gid = wgid / nig, fm = gid * WGM, gsz = (nM - fm) < WGM ? (nM - fm) : WGM;
    u.pm = fm + ((wgid % nig) % gsz); u.pn = (wgid % nig) / gsz; return true;
  }
};

template <class Epi>
DI void gemm_phase(PG8_LAS unsigned char* lds, const Gemm g, const StaticOrder& S, const Epi& E) {
  const int tid = otid(), wid = __builtin_amdgcn_readfirstlane(tid >> 6), lane = tid & 63, wr = wid >> 2, wc = wid & 3, fr = lane & 15, fq = lane >> 4;
  const int K = g.K, nt = K / BK;
  unsigned voffA[2], voffB[2];
#pragma unroll
  for (int i = 0; i < 2; ++i) { int R, C; stage_rc(tid * 16 + i * 8192, R, C);
    const int Rb = ((R >> 5) << 6) + (Epi::BMAP ? perm32(R & 31) : (R & 31));
    voffA[i] = (unsigned)(R * K + C) * 2u; voffB[i] = (unsigned)(Rb * K + C) * 2u; }
  const size_t kstep = (size_t)(BK * 2);
  const size_t hstep = (size_t)HALF * K * 2;
  const size_t hstepB = (size_t)32 * K * 2;
  const size_t tstep = 2 * hstep;
  const unsigned ldsw = (unsigned)wid * 1024u;
  const int aoff = lds_byte(wr * 64 + fr, fq * 8), boff = lds_byte(wc * 32 + fr, fq * 8);
#define PG8_SA(b, h) (((b) * 2 + (h)) * HTB)
#define PG8_SB(b, h) ((4 + (b) * 2 + (h)) * HTB)
#define PG8_STAGE(bufoff, gbase, voff) do { _Pragma("unroll") for (int _i = 0; _i < 2; ++_i) \
    __builtin_amdgcn_global_load_lds((const unsigned*)((const char*)(gbase) + (voff)[_i]), (PG8_LAS unsigned*)(lds + (bufoff) + ldsw + _i * 8192), 16, 0, 0); } while (0)
#define PG8_LDA(dst, b, h) do { _Pragma("unroll") for (int m = 0; m < 4; ++m) _Pragma("unroll") for (int k = 0; k < 2; ++k) dst[m][k] = *(const PG8_LAS bf16x8*)(lds + PG8_SA(b, h) + aoff + m * 2048 + k * 1024); } while (0)
#define PG8_LDB(dst, b, h) do { _Pragma("unroll") for (int n = 0; n < 2; ++n) _Pragma("unroll") for (int k = 0; k < 2; ++k) dst[n][k] = *(const PG8_LAS bf16x8*)(lds + PG8_SB(b, h) + boff + n * 2048 + k * 1024); } while (0)
#define PG8_MMA(ai, bj, At, Bt) do { __builtin_amdgcn_s_setprio(1); _Pragma("unroll") for (int m = 0; m < 4; ++m) _Pragma("unroll") for (int n = 0; n < 2; ++n) _Pragma("unroll") for (int k = 0; k < 2; ++k) \
    acc[ai][bj][m][n] = __builtin_amdgcn_mfma_f32_16x16x32_bf16(Bt[n][k], At[m][k], acc[ai][bj][m][n], 0, 0, 0); __builtin_amdgcn_s_setprio(0); } while (0)
#define PG8_WAIT_V(n) asm volatile("s_waitcnt vmcnt(" #n ")" ::: "memory")
#define PG8_WAIT_L(n) asm volatile("s_waitcnt lgkmcnt(" #n ")" ::: "memory")
#define PG8_BAR __builtin_amdgcn_s_barrier()
#define PG8_SCHED __builtin_amdgcn_sched_barrier(0)
  Unit cur, nxt; int ui = 0;
  if (!S.next(0, cur)) return;
  f32x4 acc[2][2][4][2];
#pragma unroll
  for (int a = 0; a < 2; ++a)
#pragma unroll
    for (int b = 0; b < 2; ++b)
#pragma unroll
      for (int m = 0; m < 4; ++m)
#pragma unroll
        for (int n = 0; n < 2; ++n) acc[a][b][m][n] = (f32x4){0.f, 0.f, 0.f, 0.f};
  bf16x8 At[4][2], B0[2][2], B1[2][2];
  const char* cA = (const char*)g.A + (size_t)cur.pm * tstep; const char* cB = (const char*)g.Bt + (size_t)cur.pn * tstep;
  PG8_STAGE(PG8_SB(0, 0), cB, voffB); PG8_STAGE(PG8_SA(0, 0), cA, voffA); PG8_STAGE(PG8_SB(0, 1), cB + hstepB, voffB); PG8_STAGE(PG8_SA(0, 1), cA + hstep, voffA);
  if (wr == 1) PG8_BAR;
  PG8_WAIT_V(4); PG8_BAR;
  PG8_STAGE(PG8_SB(1, 0), cB + kstep, voffB); PG8_STAGE(PG8_SA(1, 0), cA + kstep, voffA); PG8_STAGE(PG8_SB(1, 1), cB + hstepB + kstep, voffB);
  PG8_WAIT_V(6); PG8_BAR;
  for (;;) {
    const bool has_next = S.next(ui + 1, nxt);
    const char* nA = has_next ? (const char*)g.A + (size_t)nxt.pm * tstep : cA; const char* nB = has_next ? (const char*)g.Bt + (size_t)nxt.pn * tstep : cB;
    for (int t = 0; t < nt; t += 2) {
      const bool last = (t == nt - 2);
      const char* a1 = cA + (size_t)(t + 1) * kstep;
      const char* a2 = last ? nA : cA + (size_t)(t + 2) * kstep; const char* b2 = last ? nB : cB + (size_t)(t + 2) * kstep;
      const char* a3 = a2 + kstep; const char* b3 = b2 + kstep;
      PG8_LDB(B0, 0, 0); PG8_SCHED; PG8_LDA(At, 0, 0); PG8_STAGE(PG8_SA(1, 1), a1 + hstep, voffA);
      PG8_WAIT_L(8); PG8_BAR; PG8_WAIT_L(0); PG8_MMA(0, 0, At, B0); PG8_BAR; PG8_SCHED;
      PG8_LDB(B1, 0, 1); PG8_STAGE(PG8_SB(0, 0), b2, voffB);
      PG8_BAR; PG8_WAIT_L(0); PG8_MMA(0, 1, At, B1); PG8_BAR;
      PG8_LDA(At, 0, 1); PG8_STAGE(PG8_SA(0, 0), a2, voffA);
      PG8_BAR; PG8_WAIT_L(0); PG8_MMA(1, 0, At, B0); PG8_BAR; PG8_SCHED;
      PG8_STAGE(PG8_SB(0, 1), b2 + hstepB, voffB);
      PG8_WAIT_V(6); PG8_BAR; PG8_MMA(1, 1, At, B1); PG8_BAR;
      PG8_LDB(B0, 1, 0); PG8_SCHED; PG8_LDA(At, 1, 0); PG8_STAGE(PG8_SA(0, 1), a2 + hstep, voffA);
      PG8_WAIT_L(8); PG8_BAR; PG8_WAIT_L(0); PG8_MMA(0, 0, At, B0); PG8_BAR; PG8_SCHED;
      PG8_LDB(B1, 1, 1); PG8_STAGE(PG8_SB(1, 0), b3, voffB);
      PG8_BAR; PG8_WAIT_L(0); PG8_MMA(0, 1, At, B1); PG8_BAR;
      PG8_LDA(At, 1, 1); PG8_STAGE(PG8_SA(1, 0), a3, voffA);
      PG8_BAR; PG8_WAIT_L(0); PG8_MMA(1, 0, At, B0); PG8_BAR; PG8_SCHED;
      PG8_STAGE(PG8_SB(1, 1), b3 + hstepB, voffB);
      PG8_WAIT_V(6); PG8_BAR; PG8_MMA(1, 1, At, B1); PG8_BAR;
    }
    E(acc, cur, wr, wc, fr, fq);
    if (!has_next) break;
#pragma unroll
    for (int a = 0; a < 2; ++a)
#pragma unroll
      for (int b = 0; b < 2; ++b)
#pragma unroll
        for (int m = 0; m < 4; ++m)
#pragma unroll
          for (int n = 0; n < 2; ++n) acc[a][b][m][n] = (f32x4){0.f, 0.f, 0.f, 0.f};
    cur = nxt; cA = nA; cB = nB; ++ui;
  }
  PG8_WAIT_V(0);
  if (wr == 0) PG8_BAR;
  PG8_BAR;
#undef PG8_SA
#undef PG8_SB
#undef PG8_STAGE
#undef PG8_LDA
#undef PG8_LDB
#undef PG8_MMA
#undef PG8_WAIT_V
#undef PG8_WAIT_L
#undef PG8_BAR
#undef PG8_SCHED
}

struct EpiIn {
  static constexpr int BMAP = 0;
  const Params* p; int layer; const float* rstd;
  DI void operator()(const f32x4 (&acc)[2][2][4][2], const Unit& u, int wr, int wc, int fr, int fq) const {
    const int slot = 4 * u.pn + wc;
    bf16_t* dst = (bf16_t*)(p->ws + OFF_BIG) + (size_t)slot * SLOT_ELEMS;
    const float2* tab = (const float2*)(p->ws + OFF_ROPE);
    float* ssq_out = nullptr; const float* gain = nullptr; int rope = 0; float scale = 1.f;
    if (slot < 4) { gain = p->in[I_AQN] + layer * 64; rope = 1; scale = 0.125f * LOG2E; }
    else if (slot < 6) { gain = p->in[I_AKN] + layer * 64; rope = 1; }
    else if (slot < 10) { scale = 0.17677669529663687f * LOG2E; }
    else if (slot < 14) { }
    else if (slot < 18) { scale = 0.125f * LOG2E; }
    else if (slot < 22) { }
    else if (slot < 27) { ssq_out = (float*)(p->ws + OFF_SSQ) + (slot - 22); }
    else { rope = 2; }
    const bool is_k = (slot == 4) || (slot == 5) || (slot >= 10 && slot < 14) || (slot >= 18 && slot < 22) || (slot == 27);
    float kmx0 = 0.f, kmx1 = 0.f;
    float gv[2][2][4];
    if (gain) {
#pragma unroll
      for (int bj = 0; bj < 2; ++bj)
#pragma unroll
        for (int n = 0; n < 2; ++n)
#pragma unroll
          for (int j = 0; j < 4; ++j) gv[bj][n][j] = gain[32 * bj + 16 * n + 4 * fq + j];
    }
#pragma unroll
    for (int ai = 0; ai < 2; ++ai)
#pragma unroll
      for (int m = 0; m < 4; ++m) {
        const int tok = 256 * u.pm + 128 * ai + 64 * wr + 16 * m + fr;
        const float rsx = rstd[tok];
        float x[2][2][4];
#pragma unroll
        for (int bj = 0; bj < 2; ++bj)
#pragma unroll
          for (int n = 0; n < 2; ++n)
#pragma unroll
            for (int j = 0; j < 4; ++j) x[bj][n][j] = acc[ai][bj][m][n][j] * rsx;
        if (gain || ssq_out) {
          float ss = 0.f;
#pragma unroll
          for (int bj = 0; bj < 2; ++bj)
#pragma unroll
            for (int n = 0; n < 2; ++n)
#pragma unroll
              for (int j = 0; j < 4; ++j) ss += x[bj][n][j] * x[bj][n][j];
          ss += __shfl_xor(ss, 16); ss += __shfl_xor(ss, 32);
          if (ssq_out && fq == 0) ssq_out[(size_t)tok * 8] = ss;
          if (gain) {
            const float rstd = frsq(ss * (1.f / 64.f) + EPS);
#pragma unroll
            for (int bj = 0; bj < 2; ++bj)
#pragma unroll
              for (int n = 0; n < 2; ++n)
#pragma unroll
                for (int j = 0; j < 4; ++j) x[bj][n][j] *= rstd * gv[bj][n][j];
          }
        }
        if (rope) {
          const int s = tok & (SEQ - 1);
#pragma unroll
          for (int bj = 0; bj < 2; ++bj) {
            const int pos = (rope == 2) ? s : (bj == 0 ? (s >> 6) : (s & 63));
            const float4* tp = (const float4*)(tab + pos * 16 + 4 * fq);
            const float4 c01 = tp[0], c23 = tp[1];
            const float cs[4] = {c01.x, c01.z, c23.x, c23.z}, sn[4] = {c01.y, c01.w, c23.y, c23.w};
#pragma unroll
            for (int j = 0; j < 4; ++j) {
              const float x1 = x[bj][0][j], x2 = x[bj][1][j];
              x[bj][0][j] = x1 * cs[j] - x2 * sn[j];
              x[bj][1][j] = x1 * sn[j] + x2 * cs[j];
            }
          }
        }
#pragma unroll
        for (int bj = 0; bj < 2; ++bj)
#pragma unroll
          for (int n = 0; n < 2; ++n) {
            uint2 w;
            w.x = pk_bf16(x[bj][n][0] * scale, x[bj][n][1] * scale);
            w.y = pk_bf16(x[bj][n][2] * scale, x[bj][n][3] * scale);
            *(uint2*)(dst + (size_t)tok * 64 + 32 * bj + 16 * n + 4 * fq) = w;
          }
        if (is_k) {
          float s0 = 0.f, s1 = 0.f;
#pragma unroll
          for (int n = 0; n < 2; ++n)
#pragma unroll
            for (int j = 0; j < 4; ++j) { s0 += x[0][n][j] * x[0][n][j]; s1 += x[1][n][j] * x[1][n][j]; }
          s0 += __shfl_xor(s0, 16); s0 += __shfl_xor(s0, 32);
          s1 += __shfl_xor(s1, 16); s1 += __shfl_xor(s1, 32);
          kmx0 = fmaxf(kmx0, s0); kmx1 = fmaxf(kmx1, s1);
        }
      }
    if (is_k) {
#pragma unroll
      for (int o = 1; o < 16; o <<= 1) { kmx0 = fmaxf(kmx0, __shfl_xor(kmx0, o)); kmx1 = fmaxf(kmx1, __shfl_xor(kmx1, o)); }
      if (fr == 0 && fq == 0) {
        unsigned* km = (unsigned*)(p->ws + OFF_KMAX) + (layer * 16 + (u.pm >> 4)) * 32;
        if (slot < 6) atomic_max_pos(km + KM_A + (slot - 4), kmx0 + kmx1);
        else if (slot < 14) { atomic_max_pos(km + KM_C + (slot - 10) * 2, kmx0); atomic_max_pos(km + KM_C + (slot - 10) * 2 + 1, kmx1); }
        else if (slot < 22) atomic_max_pos(km + KM_D + (slot - 18), kmx0 + kmx1);
        else atomic_max_pos(km + KM_BR, kmx0 + kmx1);
      }
    }
  }
};

struct EpiVt {
  static constexpr int BMAP = 1;
  bf16_t* big; const float* rstd;
  DI void operator()(const f32x4 (&acc)[2][2][4][2], const Unit& u, int wr, int wc, int fr, int fq) const {
    f32x4 rs[2][2];
#pragma unroll
    for (int bj = 0; bj < 2; ++bj) {
      const float* rp = rstd + 256 * u.pn + 64 * wc + 32 * bj + 8 * fq;
      rs[bj][0] = *(const f32x4*)rp; rs[bj][1] = *(const f32x4*)(rp + 4);
    }
#pragma unroll
    for (int ai = 0; ai < 2; ++ai) {
      const int vslot = 4 * u.pm + 2 * ai + wr;
      if (vslot < 10) {
        bf16_t* dst = big + (size_t)(SL_AV + vslot) * SLOT_ELEMS;
#pragma unroll
        for (int m = 0; m < 4; ++m) {
          const int dim = 16 * m + fr;
#pragma unroll
          for (int bj = 0; bj < 2; ++bj) {
            const int tgrp = 256 * u.pn + 64 * wc + 32 * bj + (fq >> 1) * 16;
            const int b = tgrp >> 12, s = tgrp & (SEQ - 1);
            const f32x4 a = acc[ai][bj][m][0] * rs[bj][0], c = acc[ai][bj][m][1] * rs[bj][1];
            uint2 w0, w1;
            w0.x = pk_bf16(a[0], a[1]); w0.y = pk_bf16(a[2], a[3]);
            w1.x = pk_bf16(c[0], c[1]); w1.y = pk_bf16(c[2], c[3]);
            bf16_t* gp = dst + ((size_t)(b * 64 + dim)) * SEQ + s + (fq & 1) * 4;
            *(uint2*)gp = w0;
            *(uint2*)(gp + 8) = w1;
          }
        }
      }
    }
  }
};

struct EpiB16 {
  static constexpr int BMAP = 1;
  bf16_t* C; int ldc;
  DI void operator()(const f32x4 (&acc)[2][2][4][2], const Unit& u, int wr, int wc, int fr, int fq) const {
#pragma unroll
    for (int ai = 0; ai < 2; ++ai)
#pragma unroll
      for (int m = 0; m < 4; ++m) {
        bf16_t* rowp = C + (size_t)(256 * u.pm + 128 * ai + 64 * wr + 16 * m + fr) * ldc + 256 * u.pn + 64 * wc + 8 * fq;
#pragma unroll
        for (int bj = 0; bj < 2; ++bj) {
          const f32x4 a = acc[ai][bj][m][0], b = acc[ai][bj][m][1];
          u32x4 w;
          w.x = pk_bf16(a[0], a[1]); w.y = pk_bf16(a[2], a[3]); w.z = pk_bf16(b[0], b[1]); w.w = pk_bf16(b[2], b[3]);
          *(u32x4*)(rowp + 32 * bj) = w;
        }
      }
  }
};

struct EpiRelu2 {
  static constexpr int BMAP = 1;
  bf16_t* O; int ldc; const float* rstd;
  DI void operator()(const f32x4 (&acc)[2][2][4][2], const Unit& u, int wr, int wc, int fr, int fq) const {
#pragma unroll
    for (int ai = 0; ai < 2; ++ai)
#pragma unroll
      for (int m = 0; m < 4; ++m) {
        const int tok = 256 * u.pm + 128 * ai + 64 * wr + 16 * m + fr;
        bf16_t* rowp = O + (size_t)tok * ldc + 256 * u.pn + 64 * wc + 8 * fq;
        const float rsx = rstd[tok];
#pragma unroll
        for (int bj = 0; bj < 2; ++bj) {
          f32x4 a = acc[ai][bj][m][0], b = acc[ai][bj][m][1];
#pragma unroll
          for (int j = 0; j < 4; ++j) { a[j] = fmaxf(a[j], 0.f) * rsx; a[j] *= a[j]; b[j] = fmaxf(b[j], 0.f) * rsx; b[j] *= b[j]; }
          u32x4 w;
          w.x = pk_bf16(a[0], a[1]); w.y = pk_bf16(a[2], a[3]); w.z = pk_bf16(b[0], b[1]); w.w = pk_bf16(b[2], b[3]);
          *(u32x4*)(rowp + 32 * bj) = w;
        }
      }
  }
};
}

template <int G>
DI void phase_gemm8(const Params& p, int layer, char* smem) {
  PG8_LAS unsigned char* lds = (PG8_LAS unsigned char*)smem;
  bf16_t* big = (bf16_t*)(p.ws + OFF_BIG);
  const bf16_t* act = (const bf16_t*)(p.ws + OFF_ACT);
  const float* rstd = (const float*)(p.ws + OFF_RSTD);
  pg8::StaticOrder S;
  if (G == G_IN) {
    const bf16_t* W = (const bf16_t*)(p.ws + OFF_WIN) + (size_t)layer * 2560 * 1024;
    { pg8::Gemm g{act, W, T_TOK, 1792, 1024}; S.init(T_TOK, 1792, gridDim.x, blockIdx.x); pg8::EpiIn E{&p, layer, rstd}; pg8::gemm_phase(lds, g, S, E); }
    { pg8::Gemm g{W + (size_t)1792 * 1024, act, 768, T_TOK, 1024}; S.init(768, T_TOK, gridDim.x, blockIdx.x); pg8::EpiVt E{big, rstd}; pg8::gemm_phase(lds, g, S, E); }
  } else if (G == G_OUT) {
    const bf16_t* W = (const bf16_t*)(p.ws + OFF_WOUT) + (size_t)layer * 1024 * 1024;
    pg8::Gemm g{(const bf16_t*)(p.ws + OFF_OCAT), W, T_TOK, 1024, 1024}; S.init(T_TOK, 1024, gridDim.x, blockIdx.x); pg8::EpiB16 E{(bf16_t*)(p.ws + OFF_MIX), 1024}; pg8::gemm_phase(lds, g, S, E);
  } else if (G == G_UP) {
    const bf16_t* W = (const bf16_t*)(p.ws + OFF_WUP) + (size_t)layer * 4096 * 1024;
    pg8::Gemm g{act, W, T_TOK, 4096, 1024}; S.init(T_TOK, 4096, gridDim.x, blockIdx.x); pg8::EpiRelu2 E{big, 4096, rstd}; pg8::gemm_phase(lds, g, S, E);
  } else {
    const bf16_t* W = (const bf16_t*)(p.ws + OFF_WDN) + (size_t)layer * 1024 * 4096;
    pg8::Gemm g{big, W, T_TOK, 1024, 4096}; S.init(T_TOK, 1024, gridDim.x, blockIdx.x, 1); pg8::EpiB16 E{(bf16_t*)(p.ws + OFF_MIX), 1024}; pg8::gemm_phase(lds, g, S, E);
  }
}

constexpr int A_VOFF = 26624, A_STAGE = 26624 + 64 * 272, A_BIAS = 2 * A_STAGE, A_STASH = 98304;
constexpr int V_ROW = 272;

struct NaInfo { int r0q, c0, rq, cq; const float* sb; };

template <int NCH, int MODE, bool BOUND>
DI void flash_head(const bf16_t* q0p, const bf16_t* q1p, const bf16_t* q2p, const bf16_t* k0p, const bf16_t* k1p, const bf16_t* k2p,
                   const bf16_t* vt, int b, int qtok, int t0, int t1, float slope2, const NaInfo& na, char* smem,
                   f32x16& o0, f32x16& o1, float negM) {
  constexpr int KSTR = NCH * 64 + 16;
  const int tid = otid(), lane = tid & 63, r = lane & 31, h = lane >> 5;
  bf16x8 qf[NCH][2];
#pragma unroll
  for (int c = 0; c < NCH; ++c) {
    const bf16_t* qp = (c == 0) ? q0p : (c == 1) ? q1p : q2p;
#pragma unroll
    for (int ks = 0; ks < 2; ++ks) qf[c][ks] = *(const bf16x8*)(qp + (size_t)qtok * 64 + ks * 16 + 8 * h);
  }
  const int krow = tid >> 2, kseg = tid & 3;
  const size_t koff_g = ((size_t)b * SEQ + krow) * 64 + kseg * 8;
  const int kdst = krow * KSTR + kseg * 16;
  const int vd = tid >> 4, vseg = tid & 15;
  const bf16_t* vsrc = vt + ((size_t)b * 64 + vd) * SEQ + vseg * 8;
  const int vdst = A_VOFF + vd * V_ROW + vseg * 16;
  uint4 kr0, kr1, kr2, vr0, vr1;
  auto gload_k = [&](int t) {
    kr0 = *(const uint4*)(k0p + koff_g + (size_t)t * 128 * 64);
    if (NCH > 1) kr1 = *(const uint4*)(k1p + koff_g + (size_t)t * 128 * 64);
    if (NCH > 2) kr2 = *(const uint4*)(k2p + koff_g + (size_t)t * 128 * 64);
  };
  auto gload_v = [&](int t) {
    vr0 = *(const uint4*)(vsrc + t * 128);
    vr1 = *(const uint4*)(vsrc + (size_t)32 * SEQ + t * 128);
  };
  auto lstore = [&](char* st) {
    *(uint4*)(st + kdst) = kr0;
    if (NCH > 1) *(uint4*)(st + kdst + 64) = kr1;
    if (NCH > 2) *(uint4*)(st + kdst + 128) = kr2;
    *(uint4*)(st + vdst) = vr0;
    *(uint4*)(st + vdst + 32 * V_ROW) = vr1;
  };
  kr1 = make_uint4(0, 0, 0, 0); kr2 = kr1;
  gload_k(t0); gload_v(t0);
  lstore(smem);
  __syncthreads();

#pragma unroll
  for (int c = 0; c < NCH; ++c)
#pragma unroll
    for (int ks = 0; ks < 2; ++ks) asm volatile("" : "+v"(qf[c][ks]));
  float m = -1e30f, l = 0.f;
#pragma unroll
  for (int i = 0; i < 16; ++i) { o0[i] = 0.f; o1[i] = 0.f; }
  const int qpos = qtok & (SEQ - 1);

  auto stage_qk = [&](const char* cur, int t, int hf, f32x16& s0, f32x16& s1) {
#pragma unroll
    for (int i = 0; i < 16; ++i) { s0[i] = 0.f; s1[i] = 0.f; }
    const char* kb0 = cur + (hf * 64 + r) * KSTR + h * 16;
    constexpr int NC2 = NCH < 2 ? NCH : 2;
    bf16x8 ka[NC2][2], kb[NC2][2], kc[2], kd[2];
#pragma unroll
    for (int c = 0; c < NC2; ++c)
#pragma unroll
      for (int ks = 0; ks < 2; ++ks) {
        ka[c][ks] = *(const bf16x8*)(kb0 + c * 64 + ks * 32);
        kb[c][ks] = *(const bf16x8*)(kb0 + 32 * KSTR + c * 64 + ks * 32);
      }
    __builtin_amdgcn_sched_barrier(0);
    if (NCH == 3) {
#pragma unroll
      for (int ks = 0; ks < 2; ++ks) {
        kc[ks] = *(const bf16x8*)(kb0 + 2 * 64 + ks * 32);
        kd[ks] = *(const bf16x8*)(kb0 + 32 * KSTR + 2 * 64 + ks * 32);
      }
    }
#pragma unroll
    for (int c = 0; c < NC2; ++c)
#pragma unroll
      for (int ks = 0; ks < 2; ++ks) {
        s0 = MFMA(ka[c][ks], qf[c][ks], s0);
        s1 = MFMA(kb[c][ks], qf[c][ks], s1);
      }
    if (NCH == 3) {
#pragma unroll
      for (int ks = 0; ks < 2; ++ks) {
        s0 = MFMA(kc[ks], qf[NCH - 1][ks], s0);
        s1 = MFMA(kd[ks], qf[NCH - 1][ks], s1);
      }
    }
    if (MODE == 1) {
      const float rel = (float)(qpos - t * 128 - hf * 64 - 4 * h);
#pragma unroll
      for (int i = 0; i < 16; ++i) {
        const float ci = (float)((i & 3) + 8 * (i >> 2));
        s0[i] -= slope2 * fabsf(rel - ci);
        s1[i] -= slope2 * fabsf(rel - (ci + 32.f));
      }
    }
    if (MODE == 2) {
      const float* sbr = na.sb + (2 * t + hf - na.rq + 7) * 31;
#pragma unroll
      for (int i = 0; i < 16; ++i) {
        const int kc0 = crow(i, h), kc1 = 32 + crow(i, h);
        const int dc0 = min(max(kc0 - na.cq + 15, 0), 30), dc1 = min(max(kc1 - na.cq + 15, 0), 30);
        const float b0 = sbr[dc0], b1 = sbr[dc1];
        s0[i] = ((unsigned)(kc0 - na.c0) < 16u) ? s0[i] + b0 : -1e30f;
        s1[i] = ((unsigned)(kc1 - na.c0) < 16u) ? s1[i] + b1 : -1e30f;
      }
    }
  };
  auto stage_pv = [&](const char* cur, int hf, f32x16& s0, f32x16& s1) {
    if (BOUND) {
      float ps = 0.f;
#pragma unroll
      for (int i = 0; i < 16; ++i) {
        s0[i] = fexp2(s0[i]);
        s1[i] = fexp2(s1[i]);
        ps += s0[i] + s1[i];
      }
      l += ps;
    } else {
      float mx = fmaxf(s0[0], s1[0]);
#pragma unroll
      for (int i = 1; i < 16; ++i) mx = fmaxf(mx, fmaxf(s0[i], s1[i]));
      mx = fmaxf(mx, xhalf(mx));
      const float mnew = fmaxf(m, mx);
      const float alpha = fexp2(m - mnew);
      m = mnew;
      float ps = 0.f;
#pragma unroll
      for (int i = 0; i < 16; ++i) {
        s0[i] = fexp2(s0[i] - mnew);
        s1[i] = fexp2(s1[i] - mnew);
        ps += s0[i] + s1[i];
      }
      l = l * alpha + ps;
#pragma unroll
      for (int i = 0; i < 16; ++i) { o0[i] *= alpha; o1[i] *= alpha; }
    }
    const char* vb0 = cur + A_VOFF + r * V_ROW + hf * 128 + 16 * h;
#pragma unroll
    for (int kb = 0; kb < 2; ++kb)
#pragma unroll
      for (int s = 0; s < 2; ++s) {
        uint4 pu;
        if (kb == 0) {
          pu.x = pk_bf16(s0[8 * s + 0], s0[8 * s + 1]); pu.y = pk_bf16(s0[8 * s + 2], s0[8 * s + 3]);
          pu.z = pk_bf16(s0[8 * s + 4], s0[8 * s + 5]); pu.w = pk_bf16(s0[8 * s + 6], s0[8 * s + 7]);
        } else {
          pu.x = pk_bf16(s1[8 * s + 0], s1[8 * s + 1]); pu.y = pk_bf16(s1[8 * s + 2], s1[8 * s + 3]);
          pu.z = pk_bf16(s1[8 * s + 4], s1[8 * s + 5]); pu.w = pk_bf16(s1[8 * s + 6], s1[8 * s + 7]);
        }
        const bf16x8 pf = __builtin_bit_cast(bf16x8, pu);
        const int koff = (kb * 32 + 16 * s) * 2;
        {
          const bf16x8 vf = *(const bf16x8*)(vb0 + koff);
          o0 = MFMA(vf, pf, o0);
        }
        {
          const bf16x8 vf = *(const bf16x8*)(vb0 + 32 * V_ROW + koff);
          o1 = MFMA(vf, pf, o1);
        }
      }
  };
#pragma nounroll
  for (int t = t0; t < t1; ++t) {
    const char* cur = smem + ((t - t0) & 1) * A_STAGE;
    const bool more = (t + 1 < t1);
    if (more) gload_k(t + 1);
    f32x16 a0, a1, c0, c1;
    if (MODE == 2) {
      if (more) gload_v(t + 1);
      const bool act0 = (2 * t >= na.r0q) && (2 * t < na.r0q + 8), act1 = (2 * t + 1 >= na.r0q) && (2 * t + 1 < na.r0q + 8);
      if (act0) { stage_qk(cur, t, 0, a0, a1); stage_pv(cur, 0, a0, a1); }
      if (act1) { stage_qk(cur, t, 1, c0, c1); stage_pv(cur, 1, c0, c1); }
    } else {
      stage_qk(cur, t, 0, a0, a1);
      gload_v(more ? t + 1 : t);
      stage_pv(cur, 0, a0, a1);
      stage_qk(cur, t, 1, a0, a1);
      stage_pv(cur, 1, a0, a1);
    }
    if (more) lstore(smem + ((t - t0 + 1) & 1) * A_STAGE);
    __syncthreads();
  }
  l += xhalf(l);
  const float inv = 1.f / l;
#pragma unroll
  for (int i = 0; i < 16; ++i) { o0[i] *= inv; o1[i] *= inv; }
}

template <int NCH, int MODE>
DI void flash_auto(const bf16_t* q0p, const bf16_t* q1p, const bf16_t* q2p, const bf16_t* k0p, const bf16_t* k1p, const bf16_t* k2p,
                   const bf16_t* vt, int b, int qtok, int t0, int t1, float slope2, const NaInfo& na, char* smem,
                   f32x16& o0, f32x16& o1, float kmax_pad, float addb) {
  const int h = (otid() & 63) >> 5;
  float qss = 0.f;
#pragma unroll
  for (int c = 0; c < NCH; ++c) {
    const bf16_t* qp = (c == 0) ? q0p : (c == 1) ? q1p : q2p;
#pragma unroll
    for (int ks = 0; ks < 2; ++ks) {
      const uint4 u = *(const uint4*)(qp + (size_t)qtok * 64 + ks * 16 + 8 * h);
      qss += bf_lo(u.x) * bf_lo(u.x) + bf_hi(u.x) * bf_hi(u.x) + bf_lo(u.y) * bf_lo(u.y) + bf_hi(u.y) * bf_hi(u.y)
           + bf_lo(u.z) * bf_lo(u.z) + bf_hi(u.z) * bf_hi(u.z) + bf_lo(u.w) * bf_lo(u.w) + bf_hi(u.w) * bf_hi(u.w);
    }
  }
  qss += xhalf(qss);
  const float M = sqrtf(qss) * kmax_pad + addb;
  int* flag = (int*)(smem + A_BIAS + 8192 + 16);
  if (otid() == 0) *flag = 0;
  __syncthreads();
  if (!(M < 64.f)) *flag = 1;
  __syncthreads();
  if (*flag) flash_head<NCH, MODE, false>(q0p, q1p, q2p, k0p, k1p, k2p, vt, b, qtok, t0, t1, slope2, na, smem, o0, o1, 0.f);
  else if (MODE == 1) {
    const int q0 = (qtok & (SEQ - 1)) & ~255;
    const int D = (int)(214.f / slope2) + 1;
    const int ta = max(0, (q0 - D) >> 7), tb = min(32, ((q0 + 255 + D) >> 7) + 1);
    flash_head<NCH, MODE, true>(q0p, q1p, q2p, k0p, k1p, k2p, vt, b, qtok, ta, tb, slope2, na, smem, o0, o1, -M);
  }
  else flash_head<NCH, MODE, true>(q0p, q1p, q2p, k0p, k1p, k2p, vt, b, qtok, t0, t1, slope2, na, smem, o0, o1, -M);
}

template <int DUAL, bool BOUND>
DI void flash_dual(const bf16_t* qA0, const bf16_t* qA1, const bf16_t* qB0, const bf16_t* qB1, const bf16_t* k0p, const bf16_t* k1p,
                   const bf16_t* vt, int b, int qtok, int t0, int t1, float slope2, char* smem,
                   f32x16& oA0, f32x16& oA1, f32x16& oB0, f32x16& oB1) {
  constexpr int KSTR = 2 * 64 + 16;
  const int tid = otid(), lane = tid & 63, r = lane & 31, h = lane >> 5;
  bf16x8 qa[2][2], qb[2][2];
#pragma unroll
  for (int ks = 0; ks < 2; ++ks) {
    qa[0][ks] = *(const bf16x8*)(qA0 + (size_t)qtok * 64 + ks * 16 + 8 * h);
    qb[1][ks] = *(const bf16x8*)(qB1 + (size_t)qtok * 64 + ks * 16 + 8 * h);
    if (DUAL == 1) {
      qa[1][ks] = *(const bf16x8*)(qA1 + (size_t)qtok * 64 + ks * 16 + 8 * h);
      qb[0][ks] = *(const bf16x8*)(qB0 + (size_t)qtok * 64 + ks * 16 + 8 * h);
    } else { qa[1][ks] = qa[0][ks]; qb[0][ks] = qb[1][ks]; }
  }
  const int krow = tid >> 2, kseg = tid & 3;
  const size_t koff_g = ((size_t)b * SEQ + krow) * 64 + kseg * 8;
  const int kdst = krow * KSTR + kseg * 16;
  const int vd = tid >> 4, vseg = tid & 15;
  const bf16_t* vsrc = vt + ((size_t)b * 64 + vd) * SEQ + vseg * 8;
  const int vdst = A_VOFF + vd * V_ROW + vseg * 16;
  uint4 kr0, kr1, vr0, vr1;
  auto gload_k = [&](int t) {
    kr0 = *(const uint4*)(k0p + koff_g + (size_t)t * 128 * 64);
    kr1 = *(const uint4*)(k1p + koff_g + (size_t)t * 128 * 64);
  };
  auto gload_v = [&](int t) {
    vr0 = *(const uint4*)(vsrc + t * 128);
    vr1 = *(const uint4*)(vsrc + (size_t)32 * SEQ + t * 128);
  };
  auto lstore = [&](char* st) {
    *(uint4*)(st + kdst) = kr0;
    *(uint4*)(st + kdst + 64) = kr1;
    *(uint4*)(st + vdst) = vr0;
    *(uint4*)(st + vdst + 32 * V_ROW) = vr1;
  };
  gload_k(t0); gload_v(t0);
  lstore(smem);
  __syncthreads();
#pragma unroll
  for (int c = 0; c < 2; ++c)
#pragma unroll
    for (int ks = 0; ks < 2; ++ks) { asm volatile("" : "+v"(qa[c][ks])); asm volatile("" : "+v"(qb[c][ks])); }
  float mA = -1e30f, lA = 0.f, mB = -1e30f, lB = 0.f;
#pragma unroll
  for (int i = 0; i < 16; ++i) { oA0[i] = 0.f; oA1[i] = 0.f; oB0[i] = 0.f; oB1[i] = 0.f; }
  const int qpos = qtok & (SEQ - 1);

  auto softmax_pv = [&](const char* cur, int hf, f32x16& s0, f32x16& s1, float& m, float& l, f32x16& o0, f32x16& o1) {
    if (BOUND) {
      float ps = 0.f;
#pragma unroll
      for (int i = 0; i < 16; ++i) {
        s0[i] = fexp2(s0[i]);
        s1[i] = fexp2(s1[i]);
        ps += s0[i] + s1[i];
      }
      l += ps;
    } else {
      float mx = fmaxf(s0[0], s1[0]);
#pragma unroll
      for (int i = 1; i < 16; ++i) mx = fmaxf(mx, fmaxf(s0[i], s1[i]));
      mx = fmaxf(mx, xhalf(mx));
      const float mnew = fmaxf(m, mx);
      const float alpha = fexp2(m - mnew);
      m = mnew;
      float ps = 0.f;
#pragma unroll
      for (int i = 0; i < 16; ++i) {
        s0[i] = fexp2(s0[i] - mnew);
        s1[i] = fexp2(s1[i] - mnew);
        ps += s0[i] + s1[i];
      }
      l = l * alpha + ps;
#pragma unroll
      for (int i = 0; i < 16; ++i) { o0[i] *= alpha; o1[i] *= alpha; }
    }
    const char* vb0 = cur + A_VOFF + r * V_ROW + hf * 128 + 16 * h;
#pragma unroll
    for (int kb = 0; kb < 2; ++kb)
#pragma unroll
      for (int s = 0; s < 2; ++s) {
        uint4 pu;
        if (kb == 0) {
          pu.x = pk_bf16(s0[8 * s + 0], s0[8 * s + 1]); pu.y = pk_bf16(s0[8 * s + 2], s0[8 * s + 3]);
          pu.z = pk_bf16(s0[8 * s + 4], s0[8 * s + 5]); pu.w = pk_bf16(s0[8 * s + 6], s0[8 * s + 7]);
        } else {
          pu.x = pk_bf16(s1[8 * s + 0], s1[8 * s + 1]); pu.y = pk_bf16(s1[8 * s + 2], s1[8 * s + 3]);
          pu.z = pk_bf16(s1[8 * s + 4], s1[8 * s + 5]); pu.w = pk_bf16(s1[8 * s + 6], s1[8 * s + 7]);
        }
        const bf16x8 pf = __builtin_bit_cast(bf16x8, pu);
        const int koff = (kb * 32 + 16 * s) * 2;
        {
          const bf16x8 vf = *(const bf16x8*)(vb0 + koff);
          o0 = MFMA(vf, pf, o0);
        }
        {
          const bf16x8 vf = *(const bf16x8*)(vb0 + 32 * V_ROW + koff);
          o1 = MFMA(vf, pf, o1);
        }
      }
  };
#pragma nounroll
  for (int t = t0; t < t1; ++t) {
    const char* cur = smem + ((t - t0) & 1) * A_STAGE;
    const bool more = (t + 1 < t1);
    if (more) gload_k(t + 1);
#pragma nounroll
    for (int hf = 0; hf < 2; ++hf) {
      if (hf == 1) gload_v(more ? t + 1 : t);
      const char* kb0 = cur + (hf * 64 + r) * KSTR + h * 16;
      f32x16 s0, s1;
      const float rel = (float)(qpos - t * 128 - hf * 64 - 4 * h);
#pragma unroll
      for (int st = 0; st < 2; ++st) {
        constexpr int NCS = (DUAL == 1) ? 2 : 1;
        bf16x8 ka[NCS][2], kb[NCS][2];
        __builtin_amdgcn_sched_barrier(0);
#pragma unroll
        for (int cc = 0; cc < NCS; ++cc) {
          const int c = (DUAL == 1) ? cc : st;
#pragma unroll
          for (int ks = 0; ks < 2; ++ks) {
            ka[cc][ks] = *(const bf16x8*)(kb0 + c * 64 + ks * 32);
            kb[cc][ks] = *(const bf16x8*)(kb0 + 32 * KSTR + c * 64 + ks * 32);
          }
        }
        __builtin_amdgcn_sched_barrier(0);
#pragma unroll
        for (int i = 0; i < 16; ++i) { s0[i] = 0.f; s1[i] = 0.f; }
#pragma unroll
        for (int cc = 0; cc < NCS; ++cc) {
          const int c = (DUAL == 1) ? cc : st;
#pragma unroll
          for (int ks = 0; ks < 2; ++ks) {
            if (st == 0) { s0 = MFMA(ka[cc][ks], qa[c][ks], s0); s1 = MFMA(kb[cc][ks], qa[c][ks], s1); }
            else         { s0 = MFMA(ka[cc][ks], qb[c][ks], s0); s1 = MFMA(kb[cc][ks], qb[c][ks], s1); }
          }
        }
        if (DUAL == 2) {
#pragma unroll
          for (int i = 0; i < 16; ++i) {
            const float ci = (float)((i & 3) + 8 * (i >> 2));
            s0[i] -= slope2 * fabsf(rel - ci);
            s1[i] -= slope2 * fabsf(rel - (ci + 32.f));
          }
        }
        if (st == 0) softmax_pv(cur, hf, s0, s1, mA, lA, oA0, oA1);
        else         softmax_pv(cur, hf, s0, s1, mB, lB, oB0, oB1);
      }
    }
    if (more) lstore(smem + ((t - t0 + 1) & 1) * A_STAGE);
    __syncthreads();
  }
  lA += xhalf(lA); lB += xhalf(lB);
  const float ia = 1.f / lA, ib = 1.f / lB;
#pragma unroll
  for (int i = 0; i < 16; ++i) { oA0[i] *= ia; oA1[i] *= ia; oB0[i] *= ib; oB1[i] *= ib; }
}

template <int DUAL>
DI void flash_dual_auto(const bf16_t* qA0, const bf16_t* qA1, const bf16_t* qB0, const bf16_t* qB1, const bf16_t* k0p, const bf16_t* k1p,
                        const bf16_t* vt, int b, int qtok, float slope2, char* smem,
                        f32x16& oA0, f32x16& oA1, f32x16& oB0, f32x16& oB1, float kmaxA, float kmaxB) {
  const int h = (otid() & 63) >> 5;
  auto sumsq = [&](const bf16_t* qp) {
    float ss = 0.f;
#pragma unroll
    for (int ks = 0; ks < 2; ++ks) {
      const uint4 u = *(const uint4*)(qp + (size_t)qtok * 64 + ks * 16 + 8 * h);
      ss += bf_lo(u.x) * bf_lo(u.x) + bf_hi(u.x) * bf_hi(u.x) + bf_lo(u.y) * bf_lo(u.y) + bf_hi(u.y) * bf_hi(u.y)
          + bf_lo(u.z) * bf_lo(u.z) + bf_hi(u.z) * bf_hi(u.z) + bf_lo(u.w) * bf_lo(u.w) + bf_hi(u.w) * bf_hi(u.w);
    }
    return ss;
  };
  float qsA = sumsq(qA0), qsB = sumsq(qB1);
  if (DUAL == 1) { qsA += sumsq(qA1); qsB += sumsq(qB0); }
  qsA += xhalf(qsA); qsB += xhalf(qsB);
  const float M = fmaxf(sqrtf(qsA) * kmaxA, sqrtf(qsB) * kmaxB);
  int* flag = (int*)(smem + A_BIAS + 8192 + 16);
  if (otid() == 0) *flag = 0;
  __syncthreads();
  if (!(M < 64.f)) *flag = 1;
  __syncthreads();
  if (*flag) {
    NaInfo nz; nz.r0q = 0; nz.c0 = 0; nz.rq = 0; nz.cq = 0; nz.sb = nullptr;
    if (DUAL == 1) {
      flash_head<2, 0, false>(qA0, qA1, qA0, k0p, k1p, k0p, vt, b, qtok, 0, 32, 0.f, nz, smem, oA0, oA1, 0.f);
      flash_head<2, 0, false>(qB0, qB1, qB0, k0p, k1p, k0p, vt, b, qtok, 0, 32, 0.f, nz, smem, oB0, oB1, 0.f);
    } else {
      flash_head<1, 1, false>(qA0, qA0, qA0, k0p, k0p, k0p, vt, b, qtok, 0, 32, slope2, nz, smem, oA0, oA1, 0.f);
      flash_head<1, 1, false>(qB1, qB1, qB1, k1p, k1p, k1p, vt, b, qtok, 0, 32, slope2, nz, smem, oB0, oB1, 0.f);
    }
  }
  else if (DUAL == 2) {
    const int q0 = (qtok & (SEQ - 1)) & ~255;
    const int D = (int)(214.f / slope2) + 1;
    const int ta = max(0, (q0 - D) >> 7), tb = min(32, ((q0 + 255 + D) >> 7) + 1);
    flash_dual<DUAL, true>(qA0, qA1, qB0, qB1, k0p, k1p, vt, b, qtok, ta, tb, slope2, smem, oA0, oA1, oB0, oB1);
  } else flash_dual<DUAL, true>(qA0, qA1, qB0, qB1, k0p, k1p, vt, b, qtok, 0, 32, slope2, smem, oA0, oA1, oB0, oB1);
}


template <bool BOUND>
DI void flash_mla2(const bf16_t* q0p, const bf16_t* q1p, const bf16_t* q2p, const bf16_t* k0p, const bf16_t* k1p, const bf16_t* k2p,
                   const bf16_t* vt, int b, int qtokA, int qtokB, char* smem,
                   f32x16& oA0, f32x16& oA1, f32x16& oB0, f32x16& oB1) {
  constexpr int KSTR = 3 * 64 + 16;
  const int tid = otid(), lane = tid & 63, r = lane & 31, h = lane >> 5;
  bf16x8 qa[3][2], qb[3][2];
#pragma unroll
  for (int c = 0; c < 3; ++c) {
    const bf16_t* qp = (c == 0) ? q0p : (c == 1) ? q1p : q2p;
#pragma unroll
    for (int ks = 0; ks < 2; ++ks) {
      qa[c][ks] = *(const bf16x8*)(qp + (size_t)qtokA * 64 + ks * 16 + 8 * h);
      qb[c][ks] = *(const bf16x8*)(qp + (size_t)qtokB * 64 + ks * 16 + 8 * h);
    }
  }
  const int krow = tid >> 2, kseg = tid & 3;
  const size_t koff_g = ((size_t)b * SEQ + krow) * 64 + kseg * 8;
  const int kdst = krow * KSTR + kseg * 16;
  const int vd = tid >> 4, vseg = tid & 15;
  const bf16_t* vsrc = vt + ((size_t)b * 64 + vd) * SEQ + vseg * 8;
  const int vdst = A_VOFF + vd * V_ROW + vseg * 16;
  uint4 kr0, kr1, kr2, vr0, vr1;
  auto gload_k = [&](int t) {
    kr0 = *(const uint4*)(k0p + koff_g + (size_t)t * 128 * 64);
    kr1 = *(const uint4*)(k1p + koff_g + (size_t)t * 128 * 64);
    kr2 = *(const uint4*)(k2p + koff_g + (size_t)t * 128 * 64);
  };
  auto gload_v = [&](int t) {
    vr0 = *(const uint4*)(vsrc + t * 128);
    vr1 = *(const uint4*)(vsrc + (size_t)32 * SEQ + t * 128);
  };
  auto lstore = [&](char* st) {
    *(uint4*)(st + kdst) = kr0;
    *(uint4*)(st + kdst + 64) = kr1;
    *(uint4*)(st + kdst + 128) = kr2;
    *(uint4*)(st + vdst) = vr0;
    *(uint4*)(st + vdst + 32 * V_ROW) = vr1;
  };
  gload_k(0); gload_v(0);
  lstore(smem);
  __syncthreads();
#pragma unroll
  for (int c = 0; c < 3; ++c)
#pragma unroll
    for (int ks = 0; ks < 2; ++ks) { asm volatile("" : "+v"(qa[c][ks])); asm volatile("" : "+v"(qb[c][ks])); }
  float mA = -1e30f, lA = 0.f, mB = -1e30f, lB = 0.f;
#pragma unroll
  for (int i = 0; i < 16; ++i) { oA0[i] = 0.f; oA1[i] = 0.f; oB0[i] = 0.f; oB1[i] = 0.f; }

  auto softmax_pv = [&](const char* cur, int hf, f32x16& s0, f32x16& s1, float& m, float& l, f32x16& o0, f32x16& o1) {
    if (BOUND) {
      float ps = 0.f;
#pragma unroll
      for (int i = 0; i < 16; ++i) {
        s0[i] = fexp2(s0[i]);
        s1[i] = fexp2(s1[i]);
        ps += s0[i] + s1[i];
      }
      l += ps;
    } else {
      float mx = fmaxf(s0[0], s1[0]);
#pragma unroll
      for (int i = 1; i < 16; ++i) mx = fmaxf(mx, fmaxf(s0[i], s1[i]));
      mx = fmaxf(mx, xhalf(mx));
      const float mnew = fmaxf(m, mx);
      const float alpha = fexp2(m - mnew);
      m = mnew;
      float ps = 0.f;
#pragma unroll
      for (int i = 0; i < 16; ++i) {
        s0[i] = fexp2(s0[i] - mnew);
        s1[i] = fexp2(s1[i] - mnew);
        ps += s0[i] + s1[i];
      }
      l = l * alpha + ps;
#pragma unroll
      for (int i = 0; i < 16; ++i) { o0[i] *= alpha; o1[i] *= alpha; }
    }
    const char* vb0 = cur + A_VOFF + r * V_ROW + hf * 128 + 16 * h;
#pragma unroll
    for (int kb = 0; kb < 2; ++kb)
#pragma unroll
      for (int s = 0; s < 2; ++s) {
        uint4 pu;
        if (kb == 0) {
          pu.x = pk_bf16(s0[8 * s + 0], s0[8 * s + 1]); pu.y = pk_bf16(s0[8 * s + 2], s0[8 * s + 3]);
          pu.z = pk_bf16(s0[8 * s + 4], s0[8 * s + 5]); pu.w = pk_bf16(s0[8 * s + 6], s0[8 * s + 7]);
        } else {
          pu.x = pk_bf16(s1[8 * s + 0], s1[8 * s + 1]); pu.y = pk_bf16(s1[8 * s + 2], s1[8 * s + 3]);
          pu.z = pk_bf16(s1[8 * s + 4], s1[8 * s + 5]); pu.w = pk_bf16(s1[8 * s + 6], s1[8 * s + 7]);
        }
        const bf16x8 pf = __builtin_bit_cast(bf16x8, pu);
        const int koff = (kb * 32 + 16 * s) * 2;
        { const bf16x8 vf = *(const bf16x8*)(vb0 + koff); o0 = MFMA(vf, pf, o0); }
        { const bf16x8 vf = *(const bf16x8*)(vb0 + 32 * V_ROW + koff); o1 = MFMA(vf, pf, o1); }
      }
  };
#pragma nounroll
  for (int t = 0; t < 32; ++t) {
    const char* cur = smem + (t & 1) * A_STAGE;
    const bool more = (t + 1 < 32);
    if (more) gload_k(t + 1);
#pragma nounroll
    for (int hf = 0; hf < 2; ++hf) {
      if (hf == 1) gload_v(more ? t + 1 : t);
      const char* kb0 = cur + (hf * 64 + r) * KSTR + h * 16;
      f32x16 s0, s1;
#pragma unroll
      for (int st = 0; st < 2; ++st) {
        __builtin_amdgcn_sched_barrier(0);
#pragma unroll
        for (int i = 0; i < 16; ++i) { s0[i] = 0.f; s1[i] = 0.f; }
#pragma unroll
        for (int c = 0; c < 3; ++c) {
          bf16x8 ka[2], kb[2];
#pragma unroll
          for (int ks = 0; ks < 2; ++ks) {
            ka[ks] = *(const bf16x8*)(kb0 + c * 64 + ks * 32);
            kb[ks] = *(const bf16x8*)(kb0 + 32 * KSTR + c * 64 + ks * 32);
          }
#pragma unroll
          for (int ks = 0; ks < 2; ++ks) {
            if (st == 0) { s0 = MFMA(ka[ks], qa[c][ks], s0); s1 = MFMA(kb[ks], qa[c][ks], s1); }
            else         { s0 = MFMA(ka[ks], qb[c][ks], s0); s1 = MFMA(kb[ks], qb[c][ks], s1); }
          }
        }
        if (st == 0) softmax_pv(cur, hf, s0, s1, mA, lA, oA0, oA1);
        else         softmax_pv(cur, hf, s0, s1, mB, lB, oB0, oB1);
      }
    }
    if (more) lstore(smem + ((t + 1) & 1) * A_STAGE);
    __syncthreads();
  }
  lA += xhalf(lA); lB += xhalf(lB);
  const float ia = 1.f / lA, ib = 1.f / lB;
#pragma unroll
  for (int i = 0; i < 16; ++i) { oA0[i] *= ia; oA1[i] *= ia; oB0[i] *= ib; oB1[i] *= ib; }
}

DI void flash_mla2_auto(const bf16_t* q0p, const bf16_t* q1p, const bf16_t* q2p, const bf16_t* k0p, const bf16_t* k1p, const bf16_t* k2p,
                        const bf16_t* vt, int b, int qtokA, int qtokB, char* smem,
                        f32x16& oA0, f32x16& oA1, f32x16& oB0, f32x16& oB1, float kmax_pad) {
  const int h = (otid() & 63) >> 5;
  float qsA = 0.f, qsB = 0.f;
#pragma unroll
  for (int c = 0; c < 3; ++c) {
    const bf16_t* qp = (c == 0) ? q0p : (c == 1) ? q1p : q2p;
#pragma unroll
    for (int ks = 0; ks < 2; ++ks) {
      const uint4 u = *(const uint4*)(qp + (size_t)qtokA * 64 + ks * 16 + 8 * h);
      qsA += bf_lo(u.x) * bf_lo(u.x) + bf_hi(u.x) * bf_hi(u.x) + bf_lo(u.y) * bf_lo(u.y) + bf_hi(u.y) * bf_hi(u.y)
           + bf_lo(u.z) * bf_lo(u.z) + bf_hi(u.z) * bf_hi(u.z) + bf_lo(u.w) * bf_lo(u.w) + bf_hi(u.w) * bf_hi(u.w);
      const uint4 w = *(const uint4*)(qp + (size_t)qtokB * 64 + ks * 16 + 8 * h);
      qsB += bf_lo(w.x) * bf_lo(w.x) + bf_hi(w.x) * bf_hi(w.x) + bf_lo(w.y) * bf_lo(w.y) + bf_hi(w.y) * bf_hi(w.y)
           + bf_lo(w.z) * bf_lo(w.z) + bf_hi(w.z) * bf_hi(w.z) + bf_lo(w.w) * bf_lo(w.w) + bf_hi(w.w) * bf_hi(w.w);
    }
  }
  qsA += xhalf(qsA); qsB += xhalf(qsB);
  const float M = sqrtf(fmaxf(qsA, qsB)) * kmax_pad;
  int* flag = (int*)(smem + A_BIAS + 8192 + 16);
  if (otid() == 0) *flag = 0;
  __syncthreads();
  if (!(M < 64.f)) *flag = 1;
  __syncthreads();
  if (*flag) {
    NaInfo nz; nz.r0q = 0; nz.c0 = 0; nz.rq = 0; nz.cq = 0; nz.sb = nullptr;
    flash_head<3, 0, false>(q0p, q1p, q2p, k0p, k1p, k2p, vt, b, qtokA, 0, 32, 0.f, nz, smem, oA0, oA1, 0.f);
    flash_head<3, 0, false>(q0p, q1p, q2p, k0p, k1p, k2p, vt, b, qtokB, 0, 32, 0.f, nz, smem, oB0, oB1, 0.f);
  } else flash_mla2<true>(q0p, q1p, q2p, k0p, k1p, k2p, vt, b, qtokA, qtokB, smem, oA0, oA1, oB0, oB1);
}

DI float kmax_load(const Params& p, int layer, int b, int idx) {
  return __uint_as_float(((const unsigned*)(p.ws + OFF_KMAX))[(layer * 16 + b) * 32 + idx]);
}

constexpr int N_ITEMS_XCD = 208;

DI void store_o(bf16_t* dst  , const f32x16& o0, const f32x16& o1, int h) {
#pragma unroll
  for (int g = 0; g < 4; ++g) {
    uint2 u;
    u.x = pk_bf16(o0[4 * g], o0[4 * g + 1]); u.y = pk_bf16(o0[4 * g + 2], o0[4 * g + 3]);
    *(uint2*)(dst + 8 * g + 4 * h) = u;
    u.x = pk_bf16(o1[4 * g], o1[4 * g + 1]); u.y = pk_bf16(o1[4 * g + 2], o1[4 * g + 3]);
    *(uint2*)(dst + 32 + 8 * g + 4 * h) = u;
  }
}

DI void phase_attn(const Params& p, int layer, char* smem) {
  unsigned* ctr = (unsigned*)(p.ws + OFF_CTRL) + layer * 8;
  int qsel = 0;
  int* s_item = (int*)(smem + A_BIAS + 8192);
  float* sbias = (float*)(smem + A_BIAS);
  const bf16_t* big = (const bf16_t*)(p.ws + OFF_BIG);
  bf16_t* ocat = (bf16_t*)(p.ws + OFF_OCAT);
  NaInfo na0; na0.r0q = 0; na0.c0 = 0; na0.rq = 0; na0.cq = 0; na0.sb = sbias;
  for (;;) {
    const int tid = otid(), lane = tid & 63, wave = tid >> 6, r = lane & 31, h = lane >> 5;
    __syncthreads();
    const int xq = (blockIdx.x + qsel) & 7;
    if (tid == 0) *s_item = (int)atomicAdd(ctr + xq, 1u);
    __syncthreads();
    const int it = *s_item;
    if (it >= N_ITEMS_XCD) { if (++qsel >= 8) break; continue; }
    if (it < 16) {
      const int b = 2 * xq + 1 - ((it >> 3) & 1), q5 = it & 7;
      const int qtokA = b * SEQ + q5 * 512 + wave * 64 + r, qtokB = qtokA + 32;
      float ssqA = 0.f, ssqB = 0.f;
      for (int hd = 0; hd < 4; ++hd) {
        f32x16 o0, o1, u0, u1;
        const bf16_t* qn = big + (SL_BQN + hd) * SLOT_ELEMS;
        const bf16_t* qr = big + (SL_BQR + (hd >> 1)) * SLOT_ELEMS + (hd & 1) * 32;
        const bf16_t* kn = big + (SL_BKN + hd) * SLOT_ELEMS;
        const bf16_t* krp = big + SL_KR * SLOT_ELEMS;
        const float km = sqrtf(kmax_load(p, layer, b, KM_BN + hd) + kmax_load(p, layer, b, KM_BR)) * 1.01f;
        flash_mla2_auto(qn, qn + 32, qr, kn, kn + 32, krp, big + (SL_BV + hd) * SLOT_ELEMS, b, qtokA, qtokB, smem, o0, o1, u0, u1, km);
#pragma unroll
        for (int i = 0; i < 16; ++i) { ssqA += o0[i] * o0[i] + o1[i] * o1[i]; ssqB += u0[i] * u0[i] + u1[i] * u1[i]; }
        const int tid2 = otid(), tA = b * SEQ + q5 * 512 + (tid2 >> 6) * 64 + (tid2 & 31), h2 = (tid2 >> 5) & 1;
        store_o(ocat + (size_t)tA * 1024 + 256 + hd * 64, o0, o1, h2);
        store_o(ocat + (size_t)(tA + 32) * 1024 + 256 + hd * 64, u0, u1, h2);
      }
      ssqA += xhalf(ssqA); ssqB += xhalf(ssqB);
      const float rstdA = frsq(ssqA * (1.f / 256.f) + EPS), rstdB = frsq(ssqB * (1.f / 256.f) + EPS);
      const int tid3 = otid(), tA3 = b * SEQ + q5 * 512 + (tid3 >> 6) * 64 + (tid3 & 31), h3 = (tid3 >> 5) & 1;
#pragma unroll 4
      for (int j = 0; j < 64; ++j) {
        const int tk = (j < 32) ? tA3 : tA3 + 32;
        const float rs = (j < 32) ? rstdA : rstdB;
        uint2* a = (uint2*)(ocat + (size_t)tk * 1024 + 256 + 8 * (j & 31) + 4 * h3);
        uint2 u = *a;
        u.x = pk_bf16(bf_lo(u.x) * rs, bf_hi(u.x) * rs);
        u.y = pk_bf16(bf_lo(u.y) * rs, bf_hi(u.y) * rs);
        *a = u;
      }
    } else if (it < 48) {
      const int x = it - 16;
      const int b = 2 * xq + 1 - ((x >> 4) & 1), qb = x & 15;
      const int qtok = b * SEQ + qb * 256 + wave * 32 + r;
      float ssq = 0.f;
      for (int pr = 0; pr < 2; ++pr) {
        f32x16 o0, o1, u0, u1;
        const bf16_t* qa = big + (SL_AQ + 2 * pr) * SLOT_ELEMS;
        const bf16_t* qb2 = big + (SL_AQ + 2 * pr + 1) * SLOT_ELEMS;
        const bf16_t* k = big + (SL_AK + pr) * SLOT_ELEMS;
        const float km = sqrtf(kmax_load(p, layer, b, KM_A + pr)) * 1.01f;
        flash_dual_auto<1>(qa, qa + 32, qb2, qb2 + 32, k, k + 32, big + (SL_AV + pr) * SLOT_ELEMS, b, qtok, 0.f, smem, o0, o1, u0, u1, km, km);
#pragma unroll
        for (int i = 0; i < 16; ++i) ssq += o0[i] * o0[i] + o1[i] * o1[i] + u0[i] * u0[i] + u1[i] * u1[i];
        const int tid2 = otid(), qtok2 = b * SEQ + qb * 256 + (tid2 >> 6) * 32 + (tid2 & 31), h2 = (tid2 >> 5) & 1;
        store_o(ocat + (size_t)qtok2 * 1024 + (2 * pr) * 64, o0, o1, h2);
        store_o(ocat + (size_t)qtok2 * 1024 + (2 * pr + 1) * 64, u0, u1, h2);
      }
      ssq += xhalf(ssq);
      const float rstd = frsq(ssq * (1.f / 256.f) + EPS);
#pragma unroll
      for (int j = 0; j < 32; ++j) {
        uint2* a = (uint2*)(ocat + (size_t)qtok * 1024 + 8 * j + 4 * h);
        uint2 u = *a;
        u.x = pk_bf16(bf_lo(u.x) * rstd, bf_hi(u.x) * rstd);
        u.y = pk_bf16(bf_lo(u.y) * rstd, bf_hi(u.y) * rstd);
        *a = u;
      }
    } else if (it < 144 || it >= 176) {
      int hd, bsel, qb;
      if (it < 112) { const int x = it - 48; hd = 3 - (x >> 5); bsel = (x >> 4) & 1; qb = x & 15; }
      else if (it < 144) { const int x = it - 112; hd = 1; bsel = x >> 4; qb = x & 15; }
      else { const int x = it - 176; hd = 0; bsel = x >> 4; qb = x & 15; }
      const int b = 2 * xq + 1 - bsel;
      const int qtok = b * SEQ + qb * 256 + wave * 32 + r;
      const float li = ((const float*)(p.ws + OFF_CTRL))[16 + layer * 2 + 1];
      const float lam = ((const float*)(p.ws + OFF_CTRL))[16 + layer * 2];
      const float slope2 = exp2f(-2.f * (float)(hd + 1)) * LOG2E;
      const bf16_t* q = big + (SL_CQ + hd) * SLOT_ELEMS;
      const bf16_t* k = big + (SL_CK + hd) * SLOT_ELEMS;
      const bf16_t* v = big + (SL_CV + hd) * SLOT_ELEMS;
      f32x16 a0, a1, c0, c1;
      const float km0 = sqrtf(kmax_load(p, layer, b, KM_C + hd * 2)) * 1.01f, km1 = sqrtf(kmax_load(p, layer, b, KM_C + hd * 2 + 1)) * 1.01f;
      flash_dual_auto<2>(q, q, q + 32, q + 32, k, k + 32, v, b, qtok, slope2, smem, a0, a1, c0, c1, km0, km1);
      float ssq = 0.f;
#pragma unroll
      for (int i = 0; i < 16; ++i) {
        a0[i] -= lam * c0[i]; a1[i] -= lam * c1[i];
        ssq += a0[i] * a0[i] + a1[i] * a1[i];
      }
      ssq += xhalf(ssq);
      const float rstd = frsq(ssq * (1.f / 64.f) + EPS) * (1.f - li);
      const float* gc = p.in[I_GC] + layer * 64;
#pragma unroll
      for (int i = 0; i < 16; ++i) {
        a0[i] *= rstd * gc[crow(i, h)];
        a1[i] *= rstd * gc[32 + crow(i, h)];
      }
      store_o(ocat + (size_t)qtok * 1024 + 512 + hd * 64, a0, a1, h);
    } else {
      const int x = it - 144, b = 2 * xq + 1 - (x >> 4), R4 = x & 15;
      const int qtok = b * SEQ + R4 * 256 + wave * 32 + r;
      for (int e = tid; e < 4 * 465; e += NT) sbias[e] = p.in[I_RELB][layer * 4 * 465 + e] * LOG2E;
      NaInfo na;
      na.rq = R4 * 4 + (wave >> 1);
      na.cq = (wave & 1) * 32 + r;
      na.r0q = min(max(na.rq - 4, 0), 56);
      na.c0 = min(max(na.cq - 8, 0), 48);
      const int t0 = min(max(R4 * 4 - 4, 0), 56) >> 1, t1 = ((min(max(R4 * 4 + 3 - 4, 0), 56) + 7) >> 1) + 1;
      float ssq = 0.f;
      for (int hd = 0; hd < 4; ++hd) {
        f32x16 o0, o1;
        na.sb = sbias + hd * 465;
        const bf16_t* q = big + (SL_DQ + hd) * SLOT_ELEMS;
        const bf16_t* k = big + (SL_DK + hd) * SLOT_ELEMS;
        const float km = sqrtf(kmax_load(p, layer, b, KM_D + hd)) * 1.01f;
        const float addb = ((const float*)(p.ws + OFF_CTRL))[32 + layer * 4 + hd];
        flash_auto<2, 2>(q, q + 32, q, k, k + 32, k, big + (SL_DV + hd) * SLOT_ELEMS, b, qtok, t0, t1, 0.f, na, smem, o0, o1, km, addb);
#pragma unroll
        for (int i = 0; i < 16; ++i) ssq += o0[i] * o0[i] + o1[i] * o1[i];
        store_o(ocat + (size_t)qtok * 1024 + 768 + hd * 64, o0, o1, h);
      }
      ssq += xhalf(ssq);
      const float rstd = frsq(ssq * (1.f / 256.f) + EPS);
#pragma unroll
      for (int j = 0; j < 32; ++j) {
        uint2* a = (uint2*)(ocat + (size_t)qtok * 1024 + 768 + 8 * j + 4 * h);
        uint2 u = *a;
        u.x = pk_bf16(bf_lo(u.x) * rstd, bf_hi(u.x) * rstd);
        u.y = pk_bf16(bf_lo(u.y) * rstd, bf_hi(u.y) * rstd);
        *a = u;
      }
    }
  }
}


#define XB_TMO      128
#define XB_XCNT(j)  (256  + 64 * (j))
#define XB_XSUB(j)  (1280 + 64 * (j))
#define XB_XGEN(j)  (2304 + 64 * (j))
#define XB_TOP      3328
#define XB_TOPGEN   3392
#define XCD_BAR_WORDS 3456
#define XB_SPIN_CAP (1u << 20)
DI unsigned xb_ld(unsigned* p)              { return __hip_atomic_load(p, __ATOMIC_RELAXED, __HIP_MEMORY_SCOPE_AGENT); }
DI unsigned xb_add(unsigned* p, unsigned v) { return __hip_atomic_fetch_add(p, v, __ATOMIC_RELAXED, __HIP_MEMORY_SCOPE_AGENT); }
DI unsigned xb_xcc_id() { return (unsigned)__builtin_amdgcn_s_getreg((3 << 11) | 20) & 0xFu; }
#define XB_SPIN(cond, bar) do { unsigned _sp = 0; while (cond) { __builtin_amdgcn_s_sleep(1); \
    if ((++_sp & 255u) == 0u) { if (xb_ld(&(bar)[XB_TMO])) break; if (_sp > XB_SPIN_CAP) { atomicAdd(&(bar)[XB_TMO], 1u); break; } } } } while (0)
struct XcdBarrier { unsigned* bar; unsigned x; volatile PG8_LAS unsigned* st; };
DI XcdBarrier xcd_barrier_post(unsigned* bar, volatile PG8_LAS unsigned* st) {
  XcdBarrier b; b.bar = bar; b.x = xb_xcc_id(); b.st = st;
  if (threadIdx.x == 0) (void)xb_add(&bar[XB_XCNT(b.x)], 1u);
  return b;
}
DI void xcd_barrier_complete(unsigned* bar, unsigned x, unsigned& nloc, unsigned& nx) {
  const unsigned G = gridDim.x * gridDim.y * gridDim.z;
  unsigned sum, cnt, mine, sp = 0u;
  for (;;) {
    sum = 0u; cnt = 0u; mine = 0u;
#pragma unroll
    for (unsigned j = 0; j < 16; ++j) { const unsigned c = xb_ld(&bar[XB_XCNT(j)]); sum += c; cnt += (c > 0u) ? 1u : 0u; mine = (j == x) ? c : mine; }
    if (sum == G) break;
    __builtin_amdgcn_s_sleep(1);
    if ((++sp & 255u) == 0u) { if (xb_ld(&bar[XB_TMO])) break; if (sp > XB_SPIN_CAP) { atomicAdd(&bar[XB_TMO], 1u); break; } }
  }
  nloc = mine > 0u ? mine : 1u; nx = cnt > 0u ? cnt : 1u;
}
DI void xcd_barrier(const XcdBarrier& b) {
  asm volatile("s_waitcnt vmcnt(0)" ::: "memory");
  __syncthreads();
  if (threadIdx.x == 0) {
    unsigned* bar = b.bar;
    __builtin_amdgcn_s_waitcnt(0);
    unsigned nloc = b.st[0], nx = b.st[1];
    if (nloc == 0u) { xcd_barrier_complete(bar, b.x, nloc, nx); b.st[0] = nloc; b.st[1] = nx; }
    const unsigned old = xb_add(&bar[XB_XSUB(b.x)], 1u);
    const unsigned gen = old / nloc;
    if (old + 1u == (gen + 1u) * nloc) {
      __builtin_amdgcn_fence(__ATOMIC_RELEASE, "agent");
      asm volatile("s_waitcnt vmcnt(0)" ::: "memory");
      const unsigned og = xb_add(&bar[XB_TOP], 1u);
      const unsigned tg = og / nx;
      if (og + 1u == (tg + 1u) * nx) xb_add(&bar[XB_TOPGEN], 1u);
      else XB_SPIN(xb_ld(&bar[XB_TOPGEN]) == tg, bar);
      __builtin_amdgcn_fence(__ATOMIC_ACQUIRE, "agent");
      xb_add(&bar[XB_XGEN(b.x)], 1u);
      asm volatile("s_waitcnt vmcnt(0)" ::: "memory");
    } else {
      XB_SPIN(xb_ld(&bar[XB_XGEN(b.x)]) == gen, bar);
      __builtin_amdgcn_fence(__ATOMIC_ACQUIRE, "agent");
      asm volatile("s_waitcnt vmcnt(0)" ::: "memory");
    }
  }
  __syncthreads();
}

constexpr int N_PHASES = 17;
constexpr int LDS_MAIN = 131072;
constexpr int LDS_BYTES = LDS_MAIN + 16;

DI void run_phase(const Params& p, int ph, char* smem) {
  const bf16_t* mix = (const bf16_t*)(p.ws + OFF_MIX);
  bf16_t* act = (bf16_t*)(p.ws + OFF_ACT);
  float* rstd = (float*)(p.ws + OFF_RSTD);
  if (ph == 0) {
    phase_prep(p, smem);
    phase_resid(p.in[I_X], act, nullptr, nullptr, nullptr, rstd, true);
    return;
  }
  const int l = (ph - 1) >> 3, q = (ph - 1) & 7;
  switch (q) {
    case 0: phase_gemm8<G_IN>(p, l, smem); break;
    case 1: {
      for (int t = blockIdx.x; t < 256 * 7; t += gridDim.x) {
        if (t < 256 * 3) gemm_tile<G_UQ>(p, l, t, smem); else gemm_tile<G_UKV>(p, l, t - 256 * 3, smem);
      }
    } break;
    case 2: phase_attn(p, l, smem); break;
    case 3: phase_gemm8<G_OUT>(p, l, smem); break;
    case 4: phase_resid(nullptr, act, mix, p.in[I_NMIXPOST] + l * 1024, nullptr, rstd, true); break;
    case 5: phase_gemm8<G_UP>(p, l, smem); break;
    case 6: phase_gemm8<G_DOWN>(p, l, smem); break;
    case 7: if (l == 0) phase_resid(nullptr, act, mix, p.in[I_NMLPPOST] + l * 1024, nullptr, rstd, true);
            else phase_resid(nullptr, act, mix, p.in[I_NMLPPOST] + l * 1024, p.out, nullptr, false);
            break;
  }
}

__global__ void __launch_bounds__(NT) mega_kernel(Params p, int ph0, int ph1) {
  extern __shared__ __attribute__((aligned(16))) char smem[];
  cg::grid_group grid = cg::this_grid();
  volatile PG8_LAS unsigned* st = (volatile PG8_LAS unsigned*)(PG8_LAS unsigned char*)(smem + LDS_MAIN);
  if (threadIdx.x == 0) { st[0] = 0u; st[1] = 0u; }
  __syncthreads();
  XcdBarrier xb = xcd_barrier_post((unsigned*)(p.ws + OFF_BAR), st);
  for (int ph = ph0; ph < ph1; ++ph) {
    run_phase(p, ph, smem);
    if (ph + 1 < ph1) {
      if (ph0 < 0) grid.sync();
      xcd_barrier(xb);
    }
  }
}

extern "C" void kernel_launch(void* const* d_in, const int* in_sizes, int n_in, void* d_out, int out_size, void* d_ws, size_t ws_size,
                              hipStream_t stream) {
  static int grid_blocks = 0;
  if (!grid_blocks) {
    int dev = 0, cus = 0, per_cu = 0;
    hipGetDevice(&dev);
    hipDeviceGetAttribute(&cus, hipDeviceAttributeMultiprocessorCount, dev);
    hipFuncSetAttribute((const void*)mega_kernel, hipFuncAttributeMaxDynamicSharedMemorySize, LDS_BYTES);
    hipOccupancyMaxActiveBlocksPerMultiprocessor(&per_cu, mega_kernel, NT, LDS_BYTES);
    if (per_cu < 1) per_cu = 1;
    grid_blocks = cus * per_cu;
    if (ws_size < WS_NEED) fprintf(stderr, "workspace too small: %zu < %zu\n", ws_size, (size_t)WS_NEED);
  }
  Params p{};
  for (int i = 0; i < 24; ++i) p.in[i] = (const float*)d_in[i];
  p.out = (float*)d_out;
  p.ws = (unsigned char*)d_ws;
  hipMemsetAsync((unsigned char*)d_ws + OFF_BAR, 0, XCD_BAR_WORDS * sizeof(unsigned), stream);
#if MK_ONE_LAUNCH
  int ph0 = 0, ph1 = N_PHASES;
  void* args[] = {&p, &ph0, &ph1};
  hipError_t e = hipLaunchCooperativeKernel((const void*)mega_kernel, dim3(grid_blocks), dim3(NT), args, LDS_BYTES, stream);
  if (e != hipSuccess) fprintf(stderr, "cooperative launch failed: %s (grid %d)\n", hipGetErrorString(e), grid_blocks);
#else
  for (int ph = 0; ph < N_PHASES; ++ph)
    hipLaunchKernelGGL(mega_kernel, dim3(grid_blocks), dim3(NT), LDS_BYTES, stream, p, ph, ph + 1);
#endif
}
```

```cpp
#include <hip/hip_runtime.h>
#include <hip/hip_cooperative_groups.h>
#include <cstdio>
namespace cg = cooperative_groups;

#ifndef MK_ONE_LAUNCH
#define MK_ONE_LAUNCH 1
#endif

typedef unsigned short bf16_t;
typedef __attribute__((ext_vector_type(8))) short bf16x8;
typedef __attribute__((ext_vector_type(16))) float f32x16;
typedef __attribute__((ext_vector_type(2))) float f32x2;
typedef __attribute__((ext_vector_type(2))) __bf16 bf16x2_t;
#define DI __device__ __forceinline__
#define MFMA(a, b, c) __builtin_amdgcn_mfma_f32_32x32x16_bf16((a), (b), (c), 0, 0, 0)

constexpr int NT = 512;
constexpr int T_TOK = 65536;
constexpr int SEQ = 4096;
constexpr float EPS = 1e-6f;
constexpr float LOG2E = 1.4426950408889634f;
constexpr long SLOT_ELEMS = (long)T_TOK * 64;

constexpr size_t OFF_CTRL = 0;
constexpr size_t OFF_KMAX = 1024;
constexpr size_t OFF_BAR  = 8192;
constexpr size_t OFF_ROPE = 8192 + 16384;
constexpr size_t OFF_WIN  = OFF_ROPE + 4096ull * 16 * 8;
constexpr size_t OFF_WUQ  = OFF_WIN + 2ull * 2560 * 1024 * 2;
constexpr size_t OFF_WUKV = OFF_WUQ + 2ull * 384 * 192 * 2;
constexpr size_t OFF_WOUT = OFF_WUKV + 2ull * 512 * 128 * 2;
constexpr size_t OFF_WUP  = OFF_WOUT + 2ull * 1024 * 1024 * 2;
constexpr size_t OFF_WDN  = OFF_WUP + 2ull * 4096 * 1024 * 2;
constexpr size_t OFF_ACT  = OFF_WDN + 2ull * 1024 * 4096 * 2;
constexpr size_t OFF_MIX  = OFF_ACT + (size_t)T_TOK * 1024 * 2;
constexpr size_t OFF_OCAT = OFF_MIX + (size_t)T_TOK * 1024 * 2;
constexpr size_t OFF_SSQ  = OFF_MIX + (size_t)T_TOK * 1024 * 4;
constexpr size_t OFF_RSTD = OFF_SSQ + (size_t)T_TOK * 8 * 4;
constexpr size_t OFF_BIG  = OFF_RSTD + (size_t)T_TOK * 4;
constexpr size_t WS_NEED  = OFF_BIG + (size_t)T_TOK * 4096 * 2;

constexpr int SL_AQ = 0, SL_AK = 4, SL_CQ = 6, SL_CK = 10, SL_DQ = 14, SL_DK = 18, SL_CQL = 22, SL_CKV = 25, SL_KR = 27;
constexpr int SL_AV = 28, SL_CV = 30, SL_DV = 34, SL_BQN = 38, SL_BQR = 42, SL_BKN = 44, SL_BV = 48;

constexpr int KM_A = 0, KM_C = 2, KM_D = 10, KM_BN = 14, KM_BR = 18;

struct Params {
  const float* in[24];
  float* out;
  unsigned char* ws;
};
enum { I_X = 0, I_NMIXPRE, I_NMIXPOST, I_NMLPPRE, I_NMLPPOST, I_WIN, I_AQN, I_AKN, I_BCQN, I_BCKVN, I_WUQ, I_WUKV,
       I_LQ1, I_LK1, I_LQ2, I_LK2, I_RELB, I_GA, I_GB, I_GC, I_GD, I_WOUT, I_WUP, I_WDN };

DI unsigned pk_bf16(float a, float b) {
  f32x2 f = {a, b};
  bf16x2_t v = __builtin_convertvector(f, bf16x2_t);
  return __builtin_bit_cast(unsigned, v);
}
DI float bf_lo(unsigned u) { return __uint_as_float(u << 16); }
DI float bf_hi(unsigned u) { return __uint_as_float(u & 0xffff0000u); }
DI float fexp2(float x) { return __builtin_amdgcn_exp2f(x); }
DI float frsq(float x) { return __builtin_amdgcn_rsqf(x); }
DI int crow(int i, int h) { return (i & 3) + 8 * (i >> 2) + 4 * h; }
DI float xhalf(float v) { return __shfl_xor(v, 32); }
DI void atomic_max_pos(unsigned* a, float v) { atomicMax(a, __float_as_uint(v)); }
DI int otid() { int t = threadIdx.x; asm volatile("" : "+v"(t)); return t; }

DI int win_src_col(int n) {
  const int j = n >> 6, c = n & 63;
  if (j < 4) return j * 64 + c;
  if (j < 6) return 256 + (j - 4) * 64 + c;
  if (j < 10) return 864 + (j - 6) * 64 + c;
  if (j < 14) return 1120 + (j - 10) * 64 + c;
  if (j < 18) return 1632 + (j - 14) * 64 + c;
  if (j < 22) return 1888 + (j - 18) * 64 + c;
  if (j < 25) return 512 + (j - 22) * 64 + c;
  if (j < 27) return 704 + (j - 25) * 64 + c;
  if (j == 27) return c < 32 ? 832 + c : -1;
  if (j < 30) return 384 + (j - 28) * 64 + c;
  if (j < 34) return 1376 + (j - 30) * 64 + c;
  if (j < 38) return 2144 + (j - 34) * 64 + c;
  return -1;
}
DI int wuq_src_col(int n) {
  const int j = n >> 6, c = n & 63;
  if (j < 4) return j * 96 + c;
  const int hh = (j - 4) * 2 + (c >> 5);
  return hh * 96 + 64 + (c & 31);
}
DI int wukv_src_col(int n) {
  const int j = n >> 6, c = n & 63;
  if (j < 4) return j * 128 + c;
  return (j - 4) * 128 + 64 + c;
}

template <int WID>
DI void convert_weight(const Params& p, int layer, float* tile  ) {
  constexpr int K = (WID == 0) ? 1024 : (WID == 1) ? 192 : (WID == 2) ? 128 : (WID == 3) ? 1024 : (WID == 4) ? 1024 : 4096;
  constexpr int NS = (WID == 0) ? 2400 : (WID == 1) ? 384 : (WID == 2) ? 512 : (WID == 3) ? 1024 : (WID == 4) ? 4096 : 1024;
  constexpr int ND = (WID == 0) ? 2560 : NS;
  constexpr int IIN = (WID == 0) ? I_WIN : (WID == 1) ? I_WUQ : (WID == 2) ? I_WUKV : (WID == 3) ? I_WOUT : (WID == 4) ? I_WUP : I_WDN;
  constexpr size_t OFF = (WID == 0) ? OFF_WIN : (WID == 1) ? OFF_WUQ : (WID == 2) ? OFF_WUKV : (WID == 3) ? OFF_WOUT : (WID == 4) ? OFF_WUP : OFF_WDN;
  const float* src = p.in[IIN] + (size_t)layer * K * NS;
  bf16_t* dst = (bf16_t*)(p.ws + OFF) + (size_t)layer * ND * K;
  constexpr int TK = K / 64, TN = ND / 64;
  const int tid = otid();
  for (int t = blockIdx.x; t < TK * TN; t += gridDim.x) {
    const int k0 = (t % TK) * 64, n0 = (t / TK) * 64;
    __syncthreads();
#pragma unroll
    for (int j = 0; j < 8; ++j) {
      const int kk = (tid >> 6) + 8 * j, nn = tid & 63;
      const int n = n0 + nn, k = k0 + kk;
      int sc;
      if (WID == 0) sc = win_src_col(n); else if (WID == 1) sc = wuq_src_col(n); else if (WID == 2) sc = wukv_src_col(n); else sc = n;
      float v = 0.f;
      if (sc >= 0) {
        v = src[(size_t)k * NS + sc];
        float g = 1.f;
        if (WID == 0) g = p.in[I_NMIXPRE][layer * 1024 + k];
        else if (WID == 1) g = p.in[I_BCQN][layer * 192 + k];
        else if (WID == 2) g = p.in[I_BCKVN][layer * 128 + k];
        else if (WID == 3) g = (k < 256) ? p.in[I_GA][layer * 256 + k] : (k < 512) ? p.in[I_GB][layer * 256 + k - 256] : (k < 768) ? 1.f : p.in[I_GD][layer * 256 + k - 768];
        else if (WID == 4) g = p.in[I_NMLPPRE][layer * 1024 + k];
        v *= g;
      }
      tile[kk * 65 + nn] = v;
    }
    __syncthreads();
#pragma unroll
    for (int j = 0; j < 4; ++j) {
      const int nn = (tid >> 5) + 16 * j, kk2 = (tid & 31) * 2;
      const unsigned u = pk_bf16(tile[kk2 * 65 + nn], tile[(kk2 + 1) * 65 + nn]);
      *(unsigned*)(dst + (size_t)(n0 + nn) * K + k0 + kk2) = u;
    }
  }
}

DI void phase_prep(const Params& p, char* smem) {
  const int tid = otid();
  if (blockIdx.x == 0 && tid < 16) atomicExch((unsigned*)(p.ws + OFF_CTRL) + tid, 0u);
  if (blockIdx.x == 2 && tid < 8) {
    const float* rb = p.in[I_RELB] + tid * 465;
    float mx = 0.f;
    for (int i = 0; i < 465; ++i) mx = fmaxf(mx, fabsf(rb[i]));
    ((float*)(p.ws + OFF_CTRL))[32 + tid] = mx * LOG2E;
  }
  if (blockIdx.x == 1) { atomicExch((unsigned*)(p.ws + OFF_KMAX) + tid, 0u); atomicExch((unsigned*)(p.ws + OFF_KMAX) + 512 + tid, 0u); }
  if (blockIdx.x == 0 && tid >= 64 && tid < 66) {
    const int l = tid - 64;
    float d1 = 0.f, d2 = 0.f;
    for (int i = 0; i < 32; ++i) {
      d1 += p.in[I_LQ1][l * 32 + i] * p.in[I_LK1][l * 32 + i];
      d2 += p.in[I_LQ2][l * 32 + i] * p.in[I_LK2][l * 32 + i];
    }
    const float li = 0.8f - 0.6f * expf(-0.3f * (float)l);
    float* c = (float*)(p.ws + OFF_CTRL);
    c[16 + 2 * l] = expf(d1) - expf(d2) + li;
    c[17 + 2 * l] = li;
  }
  {
    float2* tab = (float2*)(p.ws + OFF_ROPE);
    for (int e = blockIdx.x * NT + tid; e < 4096 * 16; e += gridDim.x * NT) {
      const int pos = e >> 4, f = e & 15;
      const float inv = powf(10000.f, -(float)(2 * f) / 32.f);
      const float ang = (float)pos * inv;
      double rev = (double)ang * 0.15915494309189535;
      rev -= floor(rev);
      const float rf = (float)rev;
      tab[e] = make_float2(__builtin_amdgcn_cosf(rf), __builtin_amdgcn_sinf(rf));
    }
  }
  float* tile = (float*)smem;
  for (int l = 0; l < 2; ++l) {
    convert_weight<0>(p, l, tile);
    convert_weight<1>(p, l, tile);
    convert_weight<2>(p, l, tile);
    convert_weight<3>(p, l, tile);
    convert_weight<4>(p, l, tile);
    convert_weight<5>(p, l, tile);
  }
}

DI float wave_sum(float v) {
#pragma unroll
  for (int o = 32; o; o >>= 1) v += __shfl_xor(v, o);
  return v;
}
DI void phase_resid(const float* x_f32, bf16_t* xb, const bf16_t* y, const float* g_post, float* out_f32, float* rstd_out, bool write_xb) {
  const int lane = otid() & 63;
  const int gw = blockIdx.x * (NT / 64) + (otid() >> 6), nw = gridDim.x * (NT / 64);
  for (int row = gw; row < T_TOK; row += nw) {
    float xv[2][8];
#pragma unroll
    for (int j = 0; j < 2; ++j) {
      const size_t off = (size_t)row * 1024 + j * 512 + lane * 8;
      if (x_f32) {
        const float4 a = *(const float4*)(x_f32 + off), c = *(const float4*)(x_f32 + off + 4);
        xv[j][0] = a.x; xv[j][1] = a.y; xv[j][2] = a.z; xv[j][3] = a.w; xv[j][4] = c.x; xv[j][5] = c.y; xv[j][6] = c.z; xv[j][7] = c.w;
      } else {
        const uint4 u = *(const uint4*)(xb + off);
        xv[j][0] = bf_lo(u.x); xv[j][1] = bf_hi(u.x); xv[j][2] = bf_lo(u.y); xv[j][3] = bf_hi(u.y);
        xv[j][4] = bf_lo(u.z); xv[j][5] = bf_hi(u.z); xv[j][6] = bf_lo(u.w); xv[j][7] = bf_hi(u.w);
      }
    }
    if (y) {
      float yv[2][8];
      float ss = 0.f;
#pragma unroll
      for (int j = 0; j < 2; ++j) {
        const uint4 u = *(const uint4*)(y + (size_t)row * 1024 + j * 512 + lane * 8);
        yv[j][0] = bf_lo(u.x); yv[j][1] = bf_hi(u.x); yv[j][2] = bf_lo(u.y); yv[j][3] = bf_hi(u.y);
        yv[j][4] = bf_lo(u.z); yv[j][5] = bf_hi(u.z); yv[j][6] = bf_lo(u.w); yv[j][7] = bf_hi(u.w);
#pragma unroll
        for (int e = 0; e < 8; ++e) ss += yv[j][e] * yv[j][e];
      }
      ss = wave_sum(ss);
      const float rs = frsq(ss * (1.f / 1024.f) + EPS);
#pragma unroll
      for (int j = 0; j < 2; ++j) {
        const float4 g0 = *(const float4*)(g_post + j * 512 + lane * 8), g1 = *(const float4*)(g_post + j * 512 + lane * 8 + 4);
        xv[j][0] += yv[j][0] * rs * g0.x; xv[j][1] += yv[j][1] * rs * g0.y; xv[j][2] += yv[j][2] * rs * g0.z; xv[j][3] += yv[j][3] * rs * g0.w;
        xv[j][4] += yv[j][4] * rs * g1.x; xv[j][5] += yv[j][5] * rs * g1.y; xv[j][6] += yv[j][6] * rs * g1.z; xv[j][7] += yv[j][7] * rs * g1.w;
      }
    }
    if (out_f32) {
#pragma unroll
      for (int j = 0; j < 2; ++j) {
        const size_t off = (size_t)row * 1024 + j * 512 + lane * 8;
        *(float4*)(out_f32 + off) = make_float4(xv[j][0], xv[j][1], xv[j][2], xv[j][3]);
        *(float4*)(out_f32 + off + 4) = make_float4(xv[j][4], xv[j][5], xv[j][6], xv[j][7]);
      }
    }
    if (write_xb) {
#pragma unroll
      for (int j = 0; j < 2; ++j) {
        uint4 u;
        u.x = pk_bf16(xv[j][0], xv[j][1]); u.y = pk_bf16(xv[j][2], xv[j][3]); u.z = pk_bf16(xv[j][4], xv[j][5]); u.w = pk_bf16(xv[j][6], xv[j][7]);
        *(uint4*)(xb + (size_t)row * 1024 + j * 512 + lane * 8) = u;
      }
    }
    if (rstd_out) {
      float ss = 0.f;
#pragma unroll
      for (int j = 0; j < 2; ++j)
#pragma unroll
        for (int e = 0; e < 8; ++e) ss += xv[j][e] * xv[j][e];
      ss = wave_sum(ss);
      if (lane == 0) rstd_out[row] = frsq(ss * (1.f / 1024.f) + EPS);
    }
  }
}

constexpr int G_ROW = 144;
constexpr int G_XS = 256 * G_ROW;
constexpr int G_STAGE = 384 * G_ROW;

template <bool SWAP>
DI void gemm_mainloop(const bf16_t* __restrict__ Xb, long x_slab, int ldx, const bf16_t* __restrict__ Wb, int K, char* smem,
                      f32x16 (&acc)[2][2]) {
  const int tid = otid(), lane = tid & 63, wave = tid >> 6, r = lane & 31, h = lane >> 5;
  const int wm = wave >> 1, wn = wave & 1;
  const int nkt = K >> 6;
  const int lrow = tid >> 3, lseg = tid & 7;
  const bf16_t* xg = Xb + (long)lrow * ldx + lseg * 8;
  const bf16_t* wg = Wb + (long)lrow * K + lseg * 8;
  const int lds_off = lrow * G_ROW + lseg * 16;
  uint4 xr[4], wr[2];
#pragma unroll
  for (int j = 0; j < 4; ++j) xr[j] = *(const uint4*)(xg + (long)j * 64 * ldx);
#pragma unroll
  for (int j = 0; j < 2; ++j) wr[j] = *(const uint4*)(wg + (long)j * 64 * K);
#pragma unroll
  for (int j = 0; j < 4; ++j) *(uint4*)(smem + lds_off + j * 64 * G_ROW) = xr[j];
#pragma unroll
  for (int j = 0; j < 2; ++j) *(uint4*)(smem + G_XS + lds_off + j * 64 * G_ROW) = wr[j];
  __syncthreads();
  const int xs_off = (wm * 64 + r) * G_ROW + h * 16;
  const int ws_off = G_XS + (wn * 64 + r) * G_ROW + h * 16;
  for (int kt = 0; kt < nkt; ++kt) {
    const char* cur = smem + (kt & 1) * G_STAGE;
    char* nxt = smem + ((kt + 1) & 1) * G_STAGE;
    const bool more = (kt + 1 < nkt);
    if (more) {
      const bf16_t* xg2 = xg + (long)(kt + 1) * x_slab;
      const bf16_t* wg2 = wg + (kt + 1) * 64;
#pragma unroll
      for (int j = 0; j < 4; ++j) xr[j] = *(const uint4*)(xg2 + (long)j * 64 * ldx);
#pragma unroll
      for (int j = 0; j < 2; ++j) wr[j] = *(const uint4*)(wg2 + (long)j * 64 * K);
    }
#pragma unroll
    for (int ks = 0; ks < 4; ++ks) {
      bf16x8 xf[2], wf[2];
      xf[0] = *(const bf16x8*)(cur + xs_off + ks * 32);
      xf[1] = *(const bf16x8*)(cur + xs_off + 32 * G_ROW + ks * 32);
      wf[0] = *(const bf16x8*)(cur + ws_off + ks * 32);
      wf[1] = *(const bf16x8*)(cur + ws_off + 32 * G_ROW + ks * 32);
#pragma unroll
      for (int nb = 0; nb < 2; ++nb)
#pragma unroll
        for (int tb = 0; tb < 2; ++tb) {
          if (SWAP) acc[nb][tb] = MFMA(wf[nb], xf[tb], acc[nb][tb]);
          else      acc[nb][tb] = MFMA(xf[tb], wf[nb], acc[nb][tb]);
        }
    }
    if (more) {
#pragma unroll
      for (int j = 0; j < 4; ++j) *(uint4*)(nxt + lds_off + j * 64 * G_ROW) = xr[j];
#pragma unroll
      for (int j = 0; j < 2; ++j) *(uint4*)(nxt + G_XS + lds_off + j * 64 * G_ROW) = wr[j];
    }
    __syncthreads();
  }
}

DI void epi_slot(f32x16 (&acc)[2][2], bf16_t* dst  , int tok0  , const float* norm_gain,
                 int rope, const float2* tab, float* ssq_out, const float (&rs)[2], unsigned* kmax_out = nullptr) {
  const int lane = otid() & 63, r = lane & 31, h = lane >> 5;
  float kmx = 0.f;
#pragma unroll
  for (int tb = 0; tb < 2; ++tb) {
    const int tok = tok0 + tb * 32 + r;
    float sc = rs[tb];
    if (norm_gain || ssq_out) {
      float ss = 0.f;
#pragma unroll
      for (int nb = 0; nb < 2; ++nb)
#pragma unroll
        for (int i = 0; i < 16; ++i) ss += acc[nb][tb][i] * acc[nb][tb][i];
      ss += xhalf(ss);
      if (ssq_out && h == 0) ssq_out[(size_t)tok * 8] = ss;
      if (norm_gain) {
        const float rstd = frsq(ss * (1.f / 64.f) + EPS);
#pragma unroll
        for (int nb = 0; nb < 2; ++nb)
#pragma unroll
          for (int i = 0; i < 16; ++i) acc[nb][tb][i] *= rstd * norm_gain[nb * 32 + crow(i, h)];
      }
    }
    if (rope) {
      const int s = tok & (SEQ - 1);
#pragma unroll
      for (int nb = 0; nb < 2; ++nb) {
        const int pos = (rope == 2) ? s : (nb == 0 ? (s >> 6) : (s & 63));
        const float2* tp = tab + pos * 16;
#pragma unroll
        for (int i = 0; i < 8; ++i) {
          const float2 cs = tp[crow(i, h)];
          const float x1 = acc[nb][tb][i], x2 = acc[nb][tb][i + 8];
          acc[nb][tb][i] = x1 * cs.x - x2 * cs.y;
          acc[nb][tb][i + 8] = x1 * cs.y + x2 * cs.x;
        }
      }
    }
#pragma unroll
    for (int nb = 0; nb < 2; ++nb)
#pragma unroll
      for (int g = 0; g < 4; ++g) {
        uint2 u;
        u.x = pk_bf16(acc[nb][tb][4 * g] * sc, acc[nb][tb][4 * g + 1] * sc);
        u.y = pk_bf16(acc[nb][tb][4 * g + 2] * sc, acc[nb][tb][4 * g + 3] * sc);
        *(uint2*)(dst + (size_t)tok * 64 + nb * 32 + 8 * g + 4 * h) = u;
      }
    if (kmax_out) {
      float ss = 0.f;
#pragma unroll
      for (int nb = 0; nb < 2; ++nb)
#pragma unroll
        for (int i = 0; i < 16; ++i) ss += acc[nb][tb][i] * acc[nb][tb][i];
      ss += xhalf(ss);
      kmx = fmaxf(kmx, ss * sc * sc);
    }
  }
  if (kmax_out) {
#pragma unroll
    for (int o = 1; o < 32; o <<= 1) kmx = fmaxf(kmx, __shfl_xor(kmx, o));
    if (lane == 0) atomic_max_pos(kmax_out, kmx);
  }
}

DI void epi_vt(f32x16 (&acc)[2][2], bf16_t* dst  , int tok0, const float* ssq) {
  const int lane = otid() & 63, r = lane & 31, h = lane >> 5;
  const int b = tok0 >> 12, s0 = tok0 & (SEQ - 1);
#pragma unroll
  for (int tb = 0; tb < 2; ++tb) {
    if (ssq) {
#pragma unroll
      for (int i = 0; i < 16; ++i) {
        const float* q = ssq + (size_t)(tok0 + tb * 32 + crow(i, h)) * 8;
        const float rstd = frsq((q[3] + q[4]) * (1.f / 128.f) + EPS);
        acc[0][tb][i] *= rstd;
        acc[1][tb][i] *= rstd;
      }
    }
#pragma unroll
    for (int nb = 0; nb < 2; ++nb)
#pragma unroll
      for (int g = 0; g < 4; ++g) {
        uint2 u;
        u.x = pk_bf16(acc[nb][tb][4 * g], acc[nb][tb][4 * g + 1]);
        u.y = pk_bf16(acc[nb][tb][4 * g + 2], acc[nb][tb][4 * g + 3]);
        *(uint2*)(dst + ((size_t)(b * 64 + nb * 32 + r)) * SEQ + s0 + tb * 32 + (g >> 1) * 16 + h * 8 + (g & 1) * 4) = u;
      }
  }
}

DI void zero_acc(f32x16 (&acc)[2][2]) {
#pragma unroll
  for (int a = 0; a < 2; ++a)
#pragma unroll
    for (int b = 0; b < 2; ++b)
#pragma unroll
      for (int i = 0; i < 16; ++i) acc[a][b][i] = 0.f;
}

enum { G_IN = 0, G_UQ, G_UKV, G_OUT, G_UP, G_DOWN };

template <int G>
DI void gemm_tile(const Params& p, int layer, int tile, char* smem) {
  constexpr int K = (G == G_IN) ? 1024 : (G == G_UQ) ? 192 : (G == G_UKV) ? 128 : (G == G_OUT) ? 1024 : (G == G_UP) ? 1024 : 4096;
  constexpr int NTL = (G == G_IN) ? 19 : (G == G_UQ) ? 3 : (G == G_UKV) ? 4 : (G == G_OUT) ? 8 : (G == G_UP) ? 32 : 8;
  constexpr size_t WOFF = (G == G_IN) ? OFF_WIN : (G == G_UQ) ? OFF_WUQ : (G == G_UKV) ? OFF_WUKV : (G == G_OUT) ? OFF_WOUT : (G == G_UP) ? OFF_WUP : OFF_WDN;
  const int nt = tile % NTL, mt = tile / NTL;
  const int m0 = mt * 256, n0 = nt * 128;
  const int lane = otid() & 63, wave = otid() >> 6, r = lane & 31, h = lane >> 5;
  const int wm = wave >> 1, wn = wave & 1;
  bf16_t* big = (bf16_t*)(p.ws + OFF_BIG);
  const bf16_t* W = (const bf16_t*)(p.ws + WOFF) + (size_t)layer * (NTL * 128) * K + (size_t)n0 * K;
  const bf16_t* X; long x_slab; int ldx;
  if (G == G_IN || G == G_OUT || G == G_UP) { X = (const bf16_t*)(p.ws + OFF_ACT) + (size_t)m0 * 1024; x_slab = 64; ldx = 1024; }
  else if (G == G_DOWN) { X = big + (size_t)m0 * 4096; x_slab = 64; ldx = 4096; }
  else if (G == G_UQ) { X = big + SL_CQL * SLOT_ELEMS + (size_t)m0 * 64; x_slab = SLOT_ELEMS; ldx = 64; }
  else { X = big + SL_CKV * SLOT_ELEMS + (size_t)m0 * 64; x_slab = SLOT_ELEMS; ldx = 64; }
  const bool vt_tile = (G == G_IN && nt >= 14) || (G == G_UKV && nt >= 2);
  f32x16 acc[2][2];
  zero_acc(acc);
  const int tok0 = m0 + wm * 64;
  const float2* tab = (const float2*)(p.ws + OFF_ROPE);
  float* ssq = (float*)(p.ws + OFF_SSQ);
  if (vt_tile) {
    gemm_mainloop<false>(X, x_slab, ldx, W, K, smem, acc);
    if (G == G_IN) {
      const int slot = nt * 2 + wn;
      epi_vt(acc, big + slot * SLOT_ELEMS, tok0, nullptr);
    } else {
      const int slot = SL_BV + (nt - 2) * 2 + wn;
      epi_vt(acc, big + slot * SLOT_ELEMS, tok0, ssq);
    }
    return;
  }
  gemm_mainloop<true>(X, x_slab, ldx, W, K, smem, acc);
  if (G == G_IN) {
    const int slot = nt * 2 + wn;
    float rs[2] = {1.f, 1.f};
    const float* gain = nullptr; int rope = 0; float* so = nullptr;
    if (slot < 4) { gain = p.in[I_AQN] + layer * 64; rope = 1; rs[0] = rs[1] = 0.125f * LOG2E; }
    else if (slot < 6) { gain = p.in[I_AKN] + layer * 64; rope = 1; }
    else if (slot < 10) { rs[0] = rs[1] = 0.17677669529663687f * LOG2E; }
    else if (slot < 14) { }
    else if (slot < 18) { rs[0] = rs[1] = 0.125f * LOG2E; }
    else if (slot < 22) { }
    else if (slot < 27) { so = ssq + (slot - 22); }
    else { rope = 2; }
    epi_slot(acc, big + slot * SLOT_ELEMS, tok0, gain, rope, tab, so, rs);
  } else if (G == G_UQ) {
    const int slot = (nt < 2) ? SL_BQN + nt * 2 + wn : SL_BQR + wn;
    float rs[2];
#pragma unroll
    for (int tb = 0; tb < 2; ++tb) {
      const float* q = ssq + (size_t)(tok0 + tb * 32 + r) * 8;
      rs[tb] = frsq((q[0] + q[1] + q[2]) * (1.f / 192.f) + EPS) * (0.10206207261596575f * LOG2E);
    }
    epi_slot(acc, big + slot * SLOT_ELEMS, tok0, nullptr, (nt < 2) ? 0 : 2, tab, nullptr, rs);
  } else if (G == G_UKV) {
    const int slot = SL_BKN + nt * 2 + wn;
    float rs[2];
#pragma unroll
    for (int tb = 0; tb < 2; ++tb) {
      const float* q = ssq + (size_t)(tok0 + tb * 32 + r) * 8;
      rs[tb] = frsq((q[3] + q[4]) * (1.f / 128.f) + EPS);
    }
    epi_slot(acc, big + slot * SLOT_ELEMS, tok0, nullptr, 0, tab, nullptr, rs,
             (unsigned*)(p.ws + OFF_KMAX) + (layer * 16 + (tok0 >> 12)) * 32 + KM_BN + nt * 2 + wn);
  } else if (G == G_OUT || G == G_DOWN) {
    float* out = (float*)(p.ws + OFF_MIX);
#pragma unroll
    for (int tb = 0; tb < 2; ++tb)
#pragma unroll
      for (int nb = 0; nb < 2; ++nb)
#pragma unroll
        for (int g = 0; g < 4; ++g) {
          float4 v = make_float4(acc[nb][tb][4 * g], acc[nb][tb][4 * g + 1], acc[nb][tb][4 * g + 2], acc[nb][tb][4 * g + 3]);
          *(float4*)(out + (size_t)(tok0 + tb * 32 + r) * 1024 + n0 + wn * 64 + nb * 32 + 8 * g + 4 * h) = v;
        }
  } else {
#pragma unroll
    for (int tb = 0; tb < 2; ++tb)
#pragma unroll
      for (int nb = 0; nb < 2; ++nb)
#pragma unroll
        for (int g = 0; g < 4; ++g) {
          float v0 = fmaxf(acc[nb][tb][4 * g], 0.f), v1 = fmaxf(acc[nb][tb][4 * g + 1], 0.f);
          float v2 = fmaxf(acc[nb][tb][4 * g + 2], 0.f), v3 = fmaxf(acc[nb][tb][4 * g + 3], 0.f);
          uint2 u;
          u.x = pk_bf16(v0 * v0, v1 * v1);
          u.y = pk_bf16(v2 * v2, v3 * v3);
          *(uint2*)(big + (size_t)(tok0 + tb * 32 + r) * 4096 + n0 + wn * 64 + nb * 32 + 8 * g + 4 * h) = u;
        }
  }
}


namespace pg8 {
#define PG8_LAS __attribute__((address_space(3)))
typedef float f32x4 __attribute__((ext_vector_type(4)));
typedef unsigned u32x4 __attribute__((ext_vector_type(4)));
constexpr int BM = 256, BK = 64, HALF = 128, HTB = HALF * BK * 2, STAGE_BYTES = 8 * HTB, NXCD = 8, WGM = 8;
DI int lds_byte(int r, int c) { const int st = (r >> 4) * 2 + (c >> 5), rr = r & 15, cc = c & 31, ob = rr * 64 + cc * 2; return st * 1024 + (ob ^ (((ob >> 9) & 1) << 5)); }
DI void stage_rc(int b, int& R, int& C) { const int st = b / 1024, sb = b % 1024, swz = sb ^ (((sb >> 9) & 1) << 5); R = (st >> 1) * 16 + swz / 64; C = (st & 1) * 32 + (swz % 64) / 2; }
DI int perm32(int rho) { const int n = rho >> 4, i = rho & 15; return 8 * (i >> 2) + 4 * n + (i & 3); }
struct Unit { int pm, pn; };
struct Gemm { const bf16_t* A; const bf16_t* Bt; int M, N, K; int ktm = 0; };
struct StaticOrder {
  int nM, nN, nwg, G, c, rev;
  DI void init(int M, int N, int G_, int c_, int rev_ = 0) { nM = M / BM; nN = N / BM; nwg = nM * nN; G = G_; c = c_; rev = rev_; }
  DI bool next(int i, Unit& u) const {
    const int cntu = (c < nwg) ? (nwg - c + G - 1) / G : 0;
    if (i >= cntu) return false;
    const long L = (long)(rev ? cntu - 1 - i : i) * G + c;
    int wgid = (int)L; { const int q = nwg / NXCD, r = nwg % NXCD, xcd = wgid % NXCD, off = wgid / NXCD; wgid = (xcd < r ? xcd * (q + 1) : r * (q + 1) + (xcd - r) * q) + off; }
    const int nig = WGM * nN, gid = wgid / nig, fm = gid * WGM, gsz = (nM - fm) < WGM ? (nM - fm) : WGM;
    u.pm = fm + ((wgid % nig) % gsz); u.pn = (wgid % nig) / gsz; return true;
  }
};

template <class Epi>
DI void gemm_phase(PG8_LAS unsigned char* lds, const Gemm g, const StaticOrder& S, const Epi& E) {
  const int tid = otid(), wid = __builtin_amdgcn_readfirstlane(tid >> 6), lane = tid & 63, wr = wid >> 2, wc = wid & 3, fr = lane & 15, fq = lane >> 4;
  const int K = g.K, nt = K / BK;
  unsigned voffA[2], voffB[2];
#pragma unroll
  for (int i = 0; i < 2; ++i) { int R, C; stage_rc(tid * 16 + i * 8192, R, C);
    const int Rb = ((R >> 5) << 6) + (Epi::BMAP ? perm32(R & 31) : (R & 31));
    voffA[i] = (unsigned)(R * (g.ktm ? 64 : K) + C) * 2u; voffB[i] = (unsigned)(Rb * K + C) * 2u; }
  const size_t kstep = (size_t)(BK * 2);
  const size_t hstep = (size_t)HALF * K * 2;
  const size_t hstepB = (size_t)32 * K * 2;
  const size_t tstep = 2 * hstep;
  const size_t kstepA = g.ktm ? (size_t)256 * 64 * 2 : kstep;
  const size_t hstepA = g.ktm ? (size_t)HALF * 64 * 2 : hstep;
  const size_t tstepA = g.ktm ? (size_t)(K / 64) * 256 * 64 * 2 : tstep;
  const unsigned ldsw = (unsigned)wid * 1024u;
  const int aoff = lds_byte(wr * 64 + fr, fq * 8), boff = lds_byte(wc * 32 + fr, fq * 8);
#define PG8_SA(b, h) (((b) * 2 + (h)) * HTB)
#define PG8_SB(b, h) ((4 + (b) * 2 + (h)) * HTB)
#define PG8_STAGE(bufoff, gbase, voff) do { _Pragma("unroll") for (int _i = 0; _i < 2; ++_i) \
    __builtin_amdgcn_global_load_lds((const unsigned*)((const char*)(gbase) + (voff)[_i]), (PG8_LAS unsigned*)(lds + (bufoff) + ldsw + _i * 8192), 16, 0, 0); } while (0)
#define PG8_LDA(dst, b, h) do { _Pragma("unroll") for (int m = 0; m < 4; ++m) _Pragma("unroll") for (int k = 0; k < 2; ++k) dst[m][k] = *(const PG8_LAS bf16x8*)(lds + PG8_SA(b, h) + aoff + m * 2048 + k * 1024); } while (0)
#define PG8_LDB(dst, b, h) do { _Pragma("unroll") for (int n = 0; n < 2; ++n) _Pragma("unroll") for (int k = 0; k < 2; ++k) dst[n][k] = *(const PG8_LAS bf16x8*)(lds + PG8_SB(b, h) + boff + n * 2048 + k * 1024); } while (0)
#define PG8_MMA(ai, bj, At, Bt) do { __builtin_amdgcn_s_setprio(1); _Pragma("unroll") for (int m = 0; m < 4; ++m) _Pragma("unroll") for (int n = 0; n < 2; ++n) _Pragma("unroll") for (int k = 0; k < 2; ++k) \
    acc[ai][bj][m][n] = __builtin_amdgcn_mfma_f32_16x16x32_bf16(Bt[n][k], At[m][k], acc[ai][bj][m][n], 0, 0, 0); __builtin_amdgcn_s_setprio(0); } while (0)
#define PG8_WAIT_V(n) asm volatile("s_waitcnt vmcnt(" #n ")" ::: "memory")
#define PG8_WAIT_L(n) asm volatile("s_waitcnt lgkmcnt(" #n ")" ::: "memory")
#define PG8_BAR __builtin_amdgcn_s_barrier()
#define PG8_SCHED __builtin_amdgcn_sched_barrier(0)
  Unit cur, nxt; int ui = 0;
  if (!S.next(0, cur)) return;
  f32x4 acc[2][2][4][2];
#pragma unroll
  for (int a = 0; a < 2; ++a)
#pragma unroll
    for (int b = 0; b < 2; ++b)
#pragma unroll
      for (int m = 0; m < 4; ++m)
#pragma unroll
        for (int n = 0; n < 2; ++n) acc[a][b][m][n] = (f32x4){0.f, 0.f, 0.f, 0.f};
  bf16x8 At[4][2], B0[2][2], B1[2][2];
  const char* cA = (const char*)g.A + (size_t)cur.pm * tstepA; const char* cB = (const char*)g.Bt + (size_t)cur.pn * tstep;
  PG8_STAGE(PG8_SB(0, 0), cB, voffB); PG8_STAGE(PG8_SA(0, 0), cA, voffA); PG8_STAGE(PG8_SB(0, 1), cB + hstepB, voffB); PG8_STAGE(PG8_SA(0, 1), cA + hstepA, voffA);
  if (wr == 1) PG8_BAR;
  PG8_WAIT_V(4); PG8_BAR;
  PG8_STAGE(PG8_SB(1, 0), cB + kstep, voffB); PG8_STAGE(PG8_SA(1, 0), cA + kstepA, voffA); PG8_STAGE(PG8_SB(1, 1), cB + hstepB + kstep, voffB);
  PG8_WAIT_V(6); PG8_BAR;
  for (;;) {
    const bool has_next = S.next(ui + 1, nxt);
    const char* nA = has_next ? (const char*)g.A + (size_t)nxt.pm * tstepA : cA; const char* nB = has_next ? (const char*)g.Bt + (size_t)nxt.pn * tstep : cB;
    for (int t = 0; t < nt; t += 2) {
      const bool last = (t == nt - 2);
      const char* a1 = cA + (size_t)(t + 1) * kstepA;
      const char* a2 = last ? nA : cA + (size_t)(t + 2) * kstepA; const char* b2 = last ? nB : cB + (size_t)(t + 2) * kstep;
      const char* a3 = a2 + kstepA; const char* b3 = b2 + kstep;
      PG8_LDB(B0, 0, 0); PG8_SCHED; PG8_LDA(At, 0, 0); PG8_STAGE(PG8_SA(1, 1), a1 + hstepA, voffA);
      PG8_WAIT_L(8); PG8_BAR; PG8_WAIT_L(0); PG8_MMA(0, 0, At, B0); PG8_BAR; PG8_SCHED;
      PG8_LDB(B1, 0, 1); PG8_STAGE(PG8_SB(0, 0), b2, voffB);
      PG8_BAR; PG8_WAIT_L(0); PG8_MMA(0, 1, At, B1); PG8_BAR;
      PG8_LDA(At, 0, 1); PG8_STAGE(PG8_SA(0, 0), a2, voffA);
      PG8_BAR; PG8_WAIT_L(0); PG8_MMA(1, 0, At, B0); PG8_BAR; PG8_SCHED;
      PG8_STAGE(PG8_SB(0, 1), b2 + hstepB, voffB);
      PG8_WAIT_V(6); PG8_BAR; PG8_MMA(1, 1, At, B1); PG8_BAR;
      PG8_LDB(B0, 1, 0); PG8_SCHED; PG8_LDA(At, 1, 0); PG8_STAGE(PG8_SA(0, 1), a2 + hstepA, voffA);
      PG8_WAIT_L(8); PG8_BAR; PG8_WAIT_L(0); PG8_MMA(0, 0, At, B0); PG8_BAR; PG8_SCHED;
      PG8_LDB(B1, 1, 1); PG8_STAGE(PG8_SB(1, 0), b3, voffB);
      PG8_BAR; PG8_WAIT_L(0); PG8_MMA(0, 1, At, B1); PG8_BAR;
      PG8_LDA(At, 1, 1); PG8_STAGE(PG8_SA(1, 0), a3, voffA);
      PG8_BAR; PG8_WAIT_L(0); PG8_MMA(1, 0, At, B0); PG8_BAR; PG8_SCHED;
      PG8_STAGE(PG8_SB(1, 1), b3 + hstepB, voffB);
      PG8_WAIT_V(6); PG8_BAR; PG8_MMA(1, 1, At, B1); PG8_BAR;
    }
    E(acc, cur, wr, wc, fr, fq);
    if (!has_next) break;
#pragma unroll
    for (int a = 0; a < 2; ++a)
#pragma unroll
      for (int b = 0; b < 2; ++b)
#pragma unroll
        for (int m = 0; m < 4; ++m)
#pragma unroll
          for (int n = 0; n < 2; ++n) acc[a][b][m][n] = (f32x4){0.f, 0.f, 0.f, 0.f};
    cur = nxt; cA = nA; cB = nB; ++ui;
  }
  PG8_WAIT_V(0);
  if (wr == 0) PG8_BAR;
  PG8_BAR;
#undef PG8_SA
#undef PG8_SB
#undef PG8_STAGE
#undef PG8_LDA
#undef PG8_LDB
#undef PG8_MMA
#undef PG8_WAIT_V
#undef PG8_WAIT_L
#undef PG8_BAR
#undef PG8_SCHED
}

struct EpiIn {
  static constexpr int BMAP = 0;
  const Params* p; int layer; const float* rstd;
  DI void operator()(const f32x4 (&acc)[2][2][4][2], const Unit& u, int wr, int wc, int fr, int fq) const {
    const int slot = 4 * u.pn + wc;
    bf16_t* dst = (bf16_t*)(p->ws + OFF_BIG) + (size_t)slot * SLOT_ELEMS;
    const float2* tab = (const float2*)(p->ws + OFF_ROPE);
    float* ssq_out = nullptr; const float* gain = nullptr; int rope = 0; float scale = 1.f;
    if (slot < 4) { gain = p->in[I_AQN] + layer * 64; rope = 1; scale = 0.125f * LOG2E; }
    else if (slot < 6) { gain = p->in[I_AKN] + layer * 64; rope = 1; }
    else if (slot < 10) { scale = 0.17677669529663687f * LOG2E; }
    else if (slot < 14) { }
    else if (slot < 18) { scale = 0.125f * LOG2E; }
    else if (slot < 22) { }
    else if (slot < 27) { ssq_out = (float*)(p->ws + OFF_SSQ) + (slot - 22); }
    else { rope = 2; }
    const bool is_k = (slot == 4) || (slot == 5) || (slot >= 10 && slot < 14) || (slot >= 18 && slot < 22) || (slot == 27);
    float kmx0 = 0.f, kmx1 = 0.f;
    float gv[2][2][4];
    if (gain) {
#pragma unroll
      for (int bj = 0; bj < 2; ++bj)
#pragma unroll
        for (int n = 0; n < 2; ++n)
#pragma unroll
          for (int j = 0; j < 4; ++j) gv[bj][n][j] = gain[32 * bj + 16 * n + 4 * fq + j];
    }
#pragma unroll
    for (int ai = 0; ai < 2; ++ai)
#pragma unroll
      for (int m = 0; m < 4; ++m) {
        const int tok = 256 * u.pm + 128 * ai + 64 * wr + 16 * m + fr;
        const float rsx = rstd[tok];
        float x[2][2][4];
#pragma unroll
        for (int bj = 0; bj < 2; ++bj)
#pragma unroll
          for (int n = 0; n < 2; ++n)
#pragma unroll
            for (int j = 0; j < 4; ++j) x[bj][n][j] = acc[ai][bj][m][n][j] * rsx;
        if (gain || ssq_out) {
          float ss = 0.f;
#pragma unroll
          for (int bj = 0; bj < 2; ++bj)
#pragma unroll
            for (int n = 0; n < 2; ++n)
#pragma unroll
              for (int j = 0; j < 4; ++j) ss += x[bj][n][j] * x[bj][n][j];
          ss += __shfl_xor(ss, 16); ss += __shfl_xor(ss, 32);
          if (ssq_out && fq == 0) ssq_out[(size_t)tok * 8] = ss;
          if (gain) {
            const float rstd = frsq(ss * (1.f / 64.f) + EPS);
#pragma unroll
            for (int bj = 0; bj < 2; ++bj)
#pragma unroll
              for (int n = 0; n < 2; ++n)
#pragma unroll
                for (int j = 0; j < 4; ++j) x[bj][n][j] *= rstd * gv[bj][n][j];
          }
        }
        if (rope) {
          const int s = tok & (SEQ - 1);
#pragma unroll
          for (int bj = 0; bj < 2; ++bj) {
            const int pos = (rope == 2) ? s : (bj == 0 ? (s >> 6) : (s & 63));
            const float4* tp = (const float4*)(tab + pos * 16 + 4 * fq);
            const float4 c01 = tp[0], c23 = tp[1];
            const float cs[4] = {c01.x, c01.z, c23.x, c23.z}, sn[4] = {c01.y, c01.w, c23.y, c23.w};
#pragma unroll
            for (int j = 0; j < 4; ++j) {
              const float x1 = x[bj][0][j], x2 = x[bj][1][j];
              x[bj][0][j] = x1 * cs[j] - x2 * sn[j];
              x[bj][1][j] = x1 * sn[j] + x2 * cs[j];
            }
          }
        }
#pragma unroll
        for (int bj = 0; bj < 2; ++bj)
#pragma unroll
          for (int n = 0; n < 2; ++n) {
            uint2 w;
            w.x = pk_bf16(x[bj][n][0] * scale, x[bj][n][1] * scale);
            w.y = pk_bf16(x[bj][n][2] * scale, x[bj][n][3] * scale);
            *(uint2*)(dst + (size_t)tok * 64 + 32 * bj + 16 * n + 4 * fq) = w;
          }
        if (is_k) {
          float s0 = 0.f, s1 = 0.f;
#pragma unroll
          for (int n = 0; n < 2; ++n)
#pragma unroll
            for (int j = 0; j < 4; ++j) { s0 += x[0][n][j] * x[0][n][j]; s1 += x[1][n][j] * x[1][n][j]; }
          s0 += __shfl_xor(s0, 16); s0 += __shfl_xor(s0, 32);
          s1 += __shfl_xor(s1, 16); s1 += __shfl_xor(s1, 32);
          kmx0 = fmaxf(kmx0, s0); kmx1 = fmaxf(kmx1, s1);
        }
      }
    if (is_k) {
#pragma unroll
      for (int o = 1; o < 16; o <<= 1) { kmx0 = fmaxf(kmx0, __shfl_xor(kmx0, o)); kmx1 = fmaxf(kmx1, __shfl_xor(kmx1, o)); }
      if (fr == 0 && fq == 0) {
        unsigned* km = (unsigned*)(p->ws + OFF_KMAX) + (layer * 16 + (u.pm >> 4)) * 32;
        if (slot < 6) atomic_max_pos(km + KM_A + (slot - 4), kmx0 + kmx1);
        else if (slot < 14) { atomic_max_pos(km + KM_C + (slot - 10) * 2, kmx0); atomic_max_pos(km + KM_C + (slot - 10) * 2 + 1, kmx1); }
        else if (slot < 22) atomic_max_pos(km + KM_D + (slot - 18), kmx0 + kmx1);
        else atomic_max_pos(km + KM_BR, kmx0 + kmx1);
      }
    }
  }
};

struct EpiVt {
  static constexpr int BMAP = 1;
  bf16_t* big; const float* rstd;
  DI void operator()(const f32x4 (&acc)[2][2][4][2], const Unit& u, int wr, int wc, int fr, int fq) const {
    f32x4 rs[2][2];
#pragma unroll
    for (int bj = 0; bj < 2; ++bj) {
      const float* rp = rstd + 256 * u.pn + 64 * wc + 32 * bj + 8 * fq;
      rs[bj][0] = *(const f32x4*)rp; rs[bj][1] = *(const f32x4*)(rp + 4);
    }
#pragma unroll
    for (int ai = 0; ai < 2; ++ai) {
      const int vslot = 4 * u.pm + 2 * ai + wr;
      if (vslot < 10) {
        bf16_t* dst = big + (size_t)(SL_AV + vslot) * SLOT_ELEMS;
#pragma unroll
        for (int m = 0; m < 4; ++m) {
          const int dim = 16 * m + fr;
#pragma unroll
          for (int bj = 0; bj < 2; ++bj) {
            const int tgrp = 256 * u.pn + 64 * wc + 32 * bj + (fq >> 1) * 16;
            const int b = tgrp >> 12, s = tgrp & (SEQ - 1);
            const f32x4 a = acc[ai][bj][m][0] * rs[bj][0], c = acc[ai][bj][m][1] * rs[bj][1];
            uint2 w0, w1;
            w0.x = pk_bf16(a[0], a[1]); w0.y = pk_bf16(a[2], a[3]);
            w1.x = pk_bf16(c[0], c[1]); w1.y = pk_bf16(c[2], c[3]);
            bf16_t* gp = dst + ((size_t)(b * 64 + dim)) * SEQ + s + (fq & 1) * 4;
            *(uint2*)gp = w0;
            *(uint2*)(gp + 8) = w1;
          }
        }
      }
    }
  }
};

struct EpiB16 {
  static constexpr int BMAP = 1;
  bf16_t* C; int ldc;
  DI void operator()(const f32x4 (&acc)[2][2][4][2], const Unit& u, int wr, int wc, int fr, int fq) const {
#pragma unroll
    for (int ai = 0; ai < 2; ++ai)
#pragma unroll
      for (int m = 0; m < 4; ++m) {
        bf16_t* rowp = C + (size_t)(256 * u.pm + 128 * ai + 64 * wr + 16 * m + fr) * ldc + 256 * u.pn + 64 * wc + 8 * fq;
#pragma unroll
        for (int bj = 0; bj < 2; ++bj) {
          const f32x4 a = acc[ai][bj][m][0], b = acc[ai][bj][m][1];
          u32x4 w;
          w.x = pk_bf16(a[0], a[1]); w.y = pk_bf16(a[2], a[3]); w.z = pk_bf16(b[0], b[1]); w.w = pk_bf16(b[2], b[3]);
          *(u32x4*)(rowp + 32 * bj) = w;
        }
      }
  }
};

struct EpiRelu2 {
  static constexpr int BMAP = 1;
  bf16_t* O; int ldc; const float* rstd;
  DI void operator()(const f32x4 (&acc)[2][2][4][2], const Unit& u, int wr, int wc, int fr, int fq) const {
#pragma unroll
    for (int ai = 0; ai < 2; ++ai)
#pragma unroll
      for (int m = 0; m < 4; ++m) {
        const int tok = 256 * u.pm + 128 * ai + 64 * wr + 16 * m + fr;
        bf16_t* rowp = O + (size_t)(tok >> 8) * ((size_t)ldc * 256) + (size_t)(4 * u.pn + wc) * (256 * 64) + (size_t)(tok & 255) * 64 + 8 * fq;
        const float rsx = rstd[tok];
#pragma unroll
        for (int bj = 0; bj < 2; ++bj) {
          f32x4 a = acc[ai][bj][m][0], b = acc[ai][bj][m][1];
#pragma unroll
          for (int j = 0; j < 4; ++j) { a[j] = fmaxf(a[j], 0.f) * rsx; a[j] *= a[j]; b[j] = fmaxf(b[j], 0.f) * rsx; b[j] *= b[j]; }
          u32x4 w;
          w.x = pk_bf16(a[0], a[1]); w.y = pk_bf16(a[2], a[3]); w.z = pk_bf16(b[0], b[1]); w.w = pk_bf16(b[2], b[3]);
          *(u32x4*)(rowp + 32 * bj) = w;
        }
      }
  }
};
}

template <int G>
DI void phase_gemm8(const Params& p, int layer, char* smem) {
  PG8_LAS unsigned char* lds = (PG8_LAS unsigned char*)smem;
  bf16_t* big = (bf16_t*)(p.ws + OFF_BIG);
  const bf16_t* act = (const bf16_t*)(p.ws + OFF_ACT);
  const float* rstd = (const float*)(p.ws + OFF_RSTD);
  pg8::StaticOrder S;
  if (G == G_IN) {
    const bf16_t* W = (const bf16_t*)(p.ws + OFF_WIN) + (size_t)layer * 2560 * 1024;
    { pg8::Gemm g{act, W, T_TOK, 1792, 1024}; S.init(T_TOK, 1792, gridDim.x, blockIdx.x); pg8::EpiIn E{&p, layer, rstd}; pg8::gemm_phase(lds, g, S, E); }
    { pg8::Gemm g{W + (size_t)1792 * 1024, act, 768, T_TOK, 1024}; S.init(768, T_TOK, gridDim.x, blockIdx.x); pg8::EpiVt E{big, rstd}; pg8::gemm_phase(lds, g, S, E); }
  } else if (G == G_OUT) {
    const bf16_t* W = (const bf16_t*)(p.ws + OFF_WOUT) + (size_t)layer * 1024 * 1024;
    pg8::Gemm g{(const bf16_t*)(p.ws + OFF_OCAT), W, T_TOK, 1024, 1024}; S.init(T_TOK, 1024, gridDim.x, blockIdx.x); pg8::EpiB16 E{(bf16_t*)(p.ws + OFF_MIX), 1024}; pg8::gemm_phase(lds, g, S, E);
  } else if (G == G_UP) {
    const bf16_t* W = (const bf16_t*)(p.ws + OFF_WUP) + (size_t)layer * 4096 * 1024;
    pg8::Gemm g{act, W, T_TOK, 4096, 1024}; S.init(T_TOK, 4096, gridDim.x, blockIdx.x); pg8::EpiRelu2 E{big, 4096, rstd}; pg8::gemm_phase(lds, g, S, E);
  } else {
    const bf16_t* W = (const bf16_t*)(p.ws + OFF_WDN) + (size_t)layer * 1024 * 4096;
    pg8::Gemm g{big, W, T_TOK, 1024, 4096, 1}; S.init(T_TOK, 1024, gridDim.x, blockIdx.x, 1); pg8::EpiB16 E{(bf16_t*)(p.ws + OFF_MIX), 1024}; pg8::gemm_phase(lds, g, S, E);
  }
}

constexpr int A_VOFF = 26624, A_STAGE = 26624 + 64 * 272, A_BIAS = 2 * A_STAGE, A_STASH = 98304;
constexpr int V_ROW = 272;

struct NaInfo { int r0q, c0, rq, cq; const float* sb; };

template <int NCH, int MODE, bool BOUND>
DI void flash_head(const bf16_t* q0p, const bf16_t* q1p, const bf16_t* q2p, const bf16_t* k0p, const bf16_t* k1p, const bf16_t* k2p,
                   const bf16_t* vt, int b, int qtok, int t0, int t1, float slope2, const NaInfo& na, char* smem,
                   f32x16& o0, f32x16& o1, float negM) {
  constexpr int KSTR = NCH * 64 + 16;
  const int tid = otid(), lane = tid & 63, r = lane & 31, h = lane >> 5;
  bf16x8 qf[NCH][2];
#pragma unroll
  for (int c = 0; c < NCH; ++c) {
    const bf16_t* qp = (c == 0) ? q0p : (c == 1) ? q1p : q2p;
#pragma unroll
    for (int ks = 0; ks < 2; ++ks) qf[c][ks] = *(const bf16x8*)(qp + (size_t)qtok * 64 + ks * 16 + 8 * h);
  }
  const int krow = tid >> 2, kseg = tid & 3;
  const size_t koff_g = ((size_t)b * SEQ + krow) * 64 + kseg * 8;
  const int kdst = krow * KSTR + kseg * 16;
  const int vd = tid >> 4, vseg = tid & 15;
  const bf16_t* vsrc = vt + ((size_t)b * 64 + vd) * SEQ + vseg * 8;
  const int vdst = A_VOFF + vd * V_ROW + vseg * 16;
  uint4 kr0, kr1, kr2, vr0, vr1;
  auto gload_k = [&](int t) {
    kr0 = *(const uint4*)(k0p + koff_g + (size_t)t * 128 * 64);
    if (NCH > 1) kr1 = *(const uint4*)(k1p + koff_g + (size_t)t * 128 * 64);
    if (NCH > 2) kr2 = *(const uint4*)(k2p + koff_g + (size_t)t * 128 * 64);
  };
  auto gload_v = [&](int t) {
    vr0 = *(const uint4*)(vsrc + t * 128);
    vr1 = *(const uint4*)(vsrc + (size_t)32 * SEQ + t * 128);
  };
  auto lstore = [&](char* st) {
    *(uint4*)(st + kdst) = kr0;
    if (NCH > 1) *(uint4*)(st + kdst + 64) = kr1;
    if (NCH > 2) *(uint4*)(st + kdst + 128) = kr2;
    *(uint4*)(st + vdst) = vr0;
    *(uint4*)(st + vdst + 32 * V_ROW) = vr1;
  };
  kr1 = make_uint4(0, 0, 0, 0); kr2 = kr1;
  gload_k(t0); gload_v(t0);
  lstore(smem);
  __syncthreads();

#pragma unroll
  for (int c = 0; c < NCH; ++c)
#pragma unroll
    for (int ks = 0; ks < 2; ++ks) asm volatile("" : "+v"(qf[c][ks]));
  float m = -1e30f, l = 0.f;
#pragma unroll
  for (int i = 0; i < 16; ++i) { o0[i] = 0.f; o1[i] = 0.f; }
  const int qpos = qtok & (SEQ - 1);

  auto stage_qk = [&](const char* cur, int t, int hf, f32x16& s0, f32x16& s1) {
#pragma unroll
    for (int i = 0; i < 16; ++i) { s0[i] = 0.f; s1[i] = 0.f; }
    const char* kb0 = cur + (hf * 64 + r) * KSTR + h * 16;
    constexpr int NC2 = NCH < 2 ? NCH : 2;
    bf16x8 ka[NC2][2], kb[NC2][2], kc[2], kd[2];
#pragma unroll
    for (int c = 0; c < NC2; ++c)
#pragma unroll
      for (int ks = 0; ks < 2; ++ks) {
        ka[c][ks] = *(const bf16x8*)(kb0 + c * 64 + ks * 32);
        kb[c][ks] = *(const bf16x8*)(kb0 + 32 * KSTR + c * 64 + ks * 32);
      }
    __builtin_amdgcn_sched_barrier(0);
    if (NCH == 3) {
#pragma unroll
      for (int ks = 0; ks < 2; ++ks) {
        kc[ks] = *(const bf16x8*)(kb0 + 2 * 64 + ks * 32);
        kd[ks] = *(const bf16x8*)(kb0 + 32 * KSTR + 2 * 64 + ks * 32);
      }
    }
#pragma unroll
    for (int c = 0; c < NC2; ++c)
#pragma unroll
      for (int ks = 0; ks < 2; ++ks) {
        s0 = MFMA(ka[c][ks], qf[c][ks], s0);
        s1 = MFMA(kb[c][ks], qf[c][ks], s1);
      }
    if (NCH == 3) {
#pragma unroll
      for (int ks = 0; ks < 2; ++ks) {
        s0 = MFMA(kc[ks], qf[NCH - 1][ks], s0);
        s1 = MFMA(kd[ks], qf[NCH - 1][ks], s1);
      }
    }
    if (MODE == 1) {
      const float rel = (float)(qpos - t * 128 - hf * 64 - 4 * h);
#pragma unroll
      for (int i = 0; i < 16; ++i) {
        const float ci = (float)((i & 3) + 8 * (i >> 2));
        s0[i] -= slope2 * fabsf(rel - ci);
        s1[i] -= slope2 * fabsf(rel - (ci + 32.f));
      }
    }
    if (MODE == 2) {
      const float* sbr = na.sb + (2 * t + hf - na.rq + 7) * 31;
#pragma unroll
      for (int i = 0; i < 16; ++i) {
        const int kc0 = crow(i, h), kc1 = 32 + crow(i, h);
        const int dc0 = min(max(kc0 - na.cq + 15, 0), 30), dc1 = min(max(kc1 - na.cq + 15, 0), 30);
        const float b0 = sbr[dc0], b1 = sbr[dc1];
        s0[i] = ((unsigned)(kc0 - na.c0) < 16u) ? s0[i] + b0 : -1e30f;
        s1[i] = ((unsigned)(kc1 - na.c0) < 16u) ? s1[i] + b1 : -1e30f;
      }
    }
  };
  auto stage_pv = [&](const char* cur, int hf, f32x16& s0, f32x16& s1) {
    if (BOUND) {
      float ps = 0.f;
#pragma unroll
      for (int i = 0; i < 16; ++i) {
        s0[i] = fexp2(s0[i]);
        s1[i] = fexp2(s1[i]);
        ps += s0[i] + s1[i];
      }
      l += ps;
    } else {
      float mx = fmaxf(s0[0], s1[0]);
#pragma unroll
      for (int i = 1; i < 16; ++i) mx = fmaxf(mx, fmaxf(s0[i], s1[i]));
      mx = fmaxf(mx, xhalf(mx));
      const float mnew = fmaxf(m, mx);
      const float alpha = fexp2(m - mnew);
      m = mnew;
      float ps = 0.f;
#pragma unroll
      for (int i = 0; i < 16; ++i) {
        s0[i] = fexp2(s0[i] - mnew);
        s1[i] = fexp2(s1[i] - mnew);
        ps += s0[i] + s1[i];
      }
      l = l * alpha + ps;
#pragma unroll
      for (int i = 0; i < 16; ++i) { o0[i] *= alpha; o1[i] *= alpha; }
    }
    const char* vb0 = cur + A_VOFF + r * V_ROW + hf * 128 + 16 * h;
#pragma unroll
    for (int kb = 0; kb < 2; ++kb)
#pragma unroll
      for (int s = 0; s < 2; ++s) {
        uint4 pu;
        if (kb == 0) {
          pu.x = pk_bf16(s0[8 * s + 0], s0[8 * s + 1]); pu.y = pk_bf16(s0[8 * s + 2], s0[8 * s + 3]);
          pu.z = pk_bf16(s0[8 * s + 4], s0[8 * s + 5]); pu.w = pk_bf16(s0[8 * s + 6], s0[8 * s + 7]);
        } else {
          pu.x = pk_bf16(s1[8 * s + 0], s1[8 * s + 1]); pu.y = pk_bf16(s1[8 * s + 2], s1[8 * s + 3]);
          pu.z = pk_bf16(s1[8 * s + 4], s1[8 * s + 5]); pu.w = pk_bf16(s1[8 * s + 6], s1[8 * s + 7]);
        }
        const bf16x8 pf = __builtin_bit_cast(bf16x8, pu);
        const int koff = (kb * 32 + 16 * s) * 2;
        {
          const bf16x8 vf = *(const bf16x8*)(vb0 + koff);
          o0 = MFMA(vf, pf, o0);
        }
        {
          const bf16x8 vf = *(const bf16x8*)(vb0 + 32 * V_ROW + koff);
          o1 = MFMA(vf, pf, o1);
        }
      }
  };
#pragma nounroll
  for (int t = t0; t < t1; ++t) {
    const char* cur = smem + ((t - t0) & 1) * A_STAGE;
    const bool more = (t + 1 < t1);
    if (more) gload_k(t + 1);
    f32x16 a0, a1, c0, c1;
    if (MODE == 2) {
      if (more) gload_v(t + 1);
      const bool act0 = (2 * t >= na.r0q) && (2 * t < na.r0q + 8), act1 = (2 * t + 1 >= na.r0q) && (2 * t + 1 < na.r0q + 8);
      if (act0) { stage_qk(cur, t, 0, a0, a1); stage_pv(cur, 0, a0, a1); }
      if (act1) { stage_qk(cur, t, 1, c0, c1); stage_pv(cur, 1, c0, c1); }
    } else {
      stage_qk(cur, t, 0, a0, a1);
      gload_v(more ? t + 1 : t);
      stage_pv(cur, 0, a0, a1);
      stage_qk(cur, t, 1, a0, a1);
      stage_pv(cur, 1, a0, a1);
    }
    if (more) lstore(smem + ((t - t0 + 1) & 1) * A_STAGE);
    __syncthreads();
  }
  l += xhalf(l);
  const float inv = 1.f / l;
#pragma unroll
  for (int i = 0; i < 16; ++i) { o0[i] *= inv; o1[i] *= inv; }
}

template <int NCH, int MODE>
DI void flash_auto(const bf16_t* q0p, const bf16_t* q1p, const bf16_t* q2p, const bf16_t* k0p, const bf16_t* k1p, const bf16_t* k2p,
                   const bf16_t* vt, int b, int qtok, int t0, int t1, float slope2, const NaInfo& na, char* smem,
                   f32x16& o0, f32x16& o1, float kmax_pad, float addb) {
  const int h = (otid() & 63) >> 5;
  float qss = 0.f;
#pragma unroll
  for (int c = 0; c < NCH; ++c) {
    const bf16_t* qp = (c == 0) ? q0p : (c == 1) ? q1p : q2p;
#pragma unroll
    for (int ks = 0; ks < 2; ++ks) {
      const uint4 u = *(const uint4*)(qp + (size_t)qtok * 64 + ks * 16 + 8 * h);
      qss += bf_lo(u.x) * bf_lo(u.x) + bf_hi(u.x) * bf_hi(u.x) + bf_lo(u.y) * bf_lo(u.y) + bf_hi(u.y) * bf_hi(u.y)
           + bf_lo(u.z) * bf_lo(u.z) + bf_hi(u.z) * bf_hi(u.z) + bf_lo(u.w) * bf_lo(u.w) + bf_hi(u.w) * bf_hi(u.w);
    }
  }
  qss += xhalf(qss);
  const float M = sqrtf(qss) * kmax_pad + addb;
  int* flag = (int*)(smem + A_BIAS + 8192 + 16);
  if (otid() == 0) *flag = 0;
  __syncthreads();
  if (!(M < 64.f)) *flag = 1;
  __syncthreads();
  if (*flag) flash_head<NCH, MODE, false>(q0p, q1p, q2p, k0p, k1p, k2p, vt, b, qtok, t0, t1, slope2, na, smem, o0, o1, 0.f);
  else if (MODE == 1) {
    const int q0 = (qtok & (SEQ - 1)) & ~255;
    const int D = (int)(214.f / slope2) + 1;
    const int ta = max(0, (q0 - D) >> 7), tb = min(32, ((q0 + 255 + D) >> 7) + 1);
    flash_head<NCH, MODE, true>(q0p, q1p, q2p, k0p, k1p, k2p, vt, b, qtok, ta, tb, slope2, na, smem, o0, o1, -M);
  }
  else flash_head<NCH, MODE, true>(q0p, q1p, q2p, k0p, k1p, k2p, vt, b, qtok, t0, t1, slope2, na, smem, o0, o1, -M);
}

template <int DUAL, bool BOUND>
DI void flash_dual(const bf16_t* qA0, const bf16_t* qA1, const bf16_t* qB0, const bf16_t* qB1, const bf16_t* k0p, const bf16_t* k1p,
                   const bf16_t* vt, int b, int qtok, int t0, int t1, float slope2, char* smem,
                   f32x16& oA0, f32x16& oA1, f32x16& oB0, f32x16& oB1) {
  constexpr int KSTR = 2 * 64 + 16;
  const int tid = otid(), lane = tid & 63, r = lane & 31, h = lane >> 5;
  bf16x8 qa[2][2], qb[2][2];
#pragma unroll
  for (int ks = 0; ks < 2; ++ks) {
    qa[0][ks] = *(const bf16x8*)(qA0 + (size_t)qtok * 64 + ks * 16 + 8 * h);
    qb[1][ks] = *(const bf16x8*)(qB1 + (size_t)qtok * 64 + ks * 16 + 8 * h);
    if (DUAL == 1) {
      qa[1][ks] = *(const bf16x8*)(qA1 + (size_t)qtok * 64 + ks * 16 + 8 * h);
      qb[0][ks] = *(const bf16x8*)(qB0 + (size_t)qtok * 64 + ks * 16 + 8 * h);
    } else { qa[1][ks] = qa[0][ks]; qb[0][ks] = qb[1][ks]; }
  }
  const int krow = tid >> 2, kseg = tid & 3;
  const size_t koff_g = ((size_t)b * SEQ + krow) * 64 + kseg * 8;
  const int kdst = krow * KSTR + kseg * 16;
  const int vd = tid >> 4, vseg = tid & 15;
  const bf16_t* vsrc = vt + ((size_t)b * 64 + vd) * SEQ + vseg * 8;
  const int vdst = A_VOFF + vd * V_ROW + vseg * 16;
  uint4 kr0, kr1, vr0, vr1;
  auto gload_k = [&](int t) {
    kr0 = *(const uint4*)(k0p + koff_g + (size_t)t * 128 * 64);
    kr1 = *(const uint4*)(k1p + koff_g + (size_t)t * 128 * 64);
  };
  auto gload_v = [&](int t) {
    vr0 = *(const uint4*)(vsrc + t * 128);
    vr1 = *(const uint4*)(vsrc + (size_t)32 * SEQ + t * 128);
  };
  auto lstore = [&](char* st) {
    *(uint4*)(st + kdst) = kr0;
    *(uint4*)(st + kdst + 64) = kr1;
    *(uint4*)(st + vdst) = vr0;
    *(uint4*)(st + vdst + 32 * V_ROW) = vr1;
  };
  gload_k(t0); gload_v(t0);
  lstore(smem);
  __syncthreads();
#pragma unroll
  for (int c = 0; c < 2; ++c)
#pragma unroll
    for (int ks = 0; ks < 2; ++ks) { asm volatile("" : "+v"(qa[c][ks])); asm volatile("" : "+v"(qb[c][ks])); }
  float mA = -1e30f, lA = 0.f, mB = -1e30f, lB = 0.f;
#pragma unroll
  for (int i = 0; i < 16; ++i) { oA0[i] = 0.f; oA1[i] = 0.f; oB0[i] = 0.f; oB1[i] = 0.f; }
  const int qpos = qtok & (SEQ - 1);

  auto softmax_pv = [&](const char* cur, int hf, f32x16& s0, f32x16& s1, float& m, float& l, f32x16& o0, f32x16& o1) {
    if (BOUND) {
      float ps = 0.f;
#pragma unroll
      for (int i = 0; i < 16; ++i) {
        s0[i] = fexp2(s0[i]);
        s1[i] = fexp2(s1[i]);
        ps += s0[i] + s1[i];
      }
      l += ps;
    } else {
      float mx = fmaxf(s0[0], s1[0]);
#pragma unroll
      for (int i = 1; i < 16; ++i) mx = fmaxf(mx, fmaxf(s0[i], s1[i]));
      mx = fmaxf(mx, xhalf(mx));
      const float mnew = fmaxf(m, mx);
      const float alpha = fexp2(m - mnew);
      m = mnew;
      float ps = 0.f;
#pragma unroll
      for (int i = 0; i < 16; ++i) {
        s0[i] = fexp2(s0[i] - mnew);
        s1[i] = fexp2(s1[i] - mnew);
        ps += s0[i] + s1[i];
      }
      l = l * alpha + ps;
#pragma unroll
      for (int i = 0; i < 16; ++i) { o0[i] *= alpha; o1[i] *= alpha; }
    }
    const char* vb0 = cur + A_VOFF + r * V_ROW + hf * 128 + 16 * h;
#pragma unroll
    for (int kb = 0; kb < 2; ++kb)
#pragma unroll
      for (int s = 0; s < 2; ++s) {
        uint4 pu;
        if (kb == 0) {
          pu.x = pk_bf16(s0[8 * s + 0], s0[8 * s + 1]); pu.y = pk_bf16(s0[8 * s + 2], s0[8 * s + 3]);
          pu.z = pk_bf16(s0[8 * s + 4], s0[8 * s + 5]); pu.w = pk_bf16(s0[8 * s + 6], s0[8 * s + 7]);
        } else {
          pu.x = pk_bf16(s1[8 * s + 0], s1[8 * s + 1]); pu.y = pk_bf16(s1[8 * s + 2], s1[8 * s + 3]);
          pu.z = pk_bf16(s1[8 * s + 4], s1[8 * s + 5]); pu.w = pk_bf16(s1[8 * s + 6], s1[8 * s + 7]);
        }
        const bf16x8 pf = __builtin_bit_cast(bf16x8, pu);
        const int koff = (kb * 32 + 16 * s) * 2;
        {
          const bf16x8 vf = *(const bf16x8*)(vb0 + koff);
          o0 = MFMA(vf, pf, o0);
        }
        {
          const bf16x8 vf = *(const bf16x8*)(vb0 + 32 * V_ROW + koff);
          o1 = MFMA(vf, pf, o1);
        }
      }
  };
#pragma nounroll
  for (int t = t0; t < t1; ++t) {
    const char* cur = smem + ((t - t0) & 1) * A_STAGE;
    const bool more = (t + 1 < t1);
    if (more) gload_k(t + 1);
#pragma nounroll
    for (int hf = 0; hf < 2; ++hf) {
      if (hf == 1) gload_v(more ? t + 1 : t);
      const char* kb0 = cur + (hf * 64 + r) * KSTR + h * 16;
      f32x16 s0, s1;
      const float rel = (float)(qpos - t * 128 - hf * 64 - 4 * h);
#pragma unroll
      for (int st = 0; st < 2; ++st) {
        constexpr int NCS = (DUAL == 1) ? 2 : 1;
        bf16x8 ka[NCS][2], kb[NCS][2];
        __builtin_amdgcn_sched_barrier(0);
#pragma unroll
        for (int cc = 0; cc < NCS; ++cc) {
          const int c = (DUAL == 1) ? cc : st;
#pragma unroll
          for (int ks = 0; ks < 2; ++ks) {
            ka[cc][ks] = *(const bf16x8*)(kb0 + c * 64 + ks * 32);
            kb[cc][ks] = *(const bf16x8*)(kb0 + 32 * KSTR + c * 64 + ks * 32);
          }
        }
        __builtin_amdgcn_sched_barrier(0);
#pragma unroll
        for (int i = 0; i < 16; ++i) { s0[i] = 0.f; s1[i] = 0.f; }
#pragma unroll
        for (int cc = 0; cc < NCS; ++cc) {
          const int c = (DUAL == 1) ? cc : st;
#pragma unroll
          for (int ks = 0; ks < 2; ++ks) {
            if (st == 0) { s0 = MFMA(ka[cc][ks], qa[c][ks], s0); s1 = MFMA(kb[cc][ks], qa[c][ks], s1); }
            else         { s0 = MFMA(ka[cc][ks], qb[c][ks], s0); s1 = MFMA(kb[cc][ks], qb[c][ks], s1); }
          }
        }
        if (DUAL == 2) {
#pragma unroll
          for (int i = 0; i < 16; ++i) {
            const float ci = (float)((i & 3) + 8 * (i >> 2));
            s0[i] -= slope2 * fabsf(rel - ci);
            s1[i] -= slope2 * fabsf(rel - (ci + 32.f));
          }
        }
        if (st == 0) softmax_pv(cur, hf, s0, s1, mA, lA, oA0, oA1);
        else         softmax_pv(cur, hf, s0, s1, mB, lB, oB0, oB1);
      }
    }
    if (more) lstore(smem + ((t - t0 + 1) & 1) * A_STAGE);
    __syncthreads();
  }
  lA += xhalf(lA); lB += xhalf(lB);
  const float ia = 1.f / lA, ib = 1.f / lB;
#pragma unroll
  for (int i = 0; i < 16; ++i) { oA0[i] *= ia; oA1[i] *= ia; oB0[i] *= ib; oB1[i] *= ib; }
}

template <int DUAL>
DI void flash_dual_auto(const bf16_t* qA0, const bf16_t* qA1, const bf16_t* qB0, const bf16_t* qB1, const bf16_t* k0p, const bf16_t* k1p,
                        const bf16_t* vt, int b, int qtok, float slope2, char* smem,
                        f32x16& oA0, f32x16& oA1, f32x16& oB0, f32x16& oB1, float kmaxA, float kmaxB) {
  const int h = (otid() & 63) >> 5;
  auto sumsq = [&](const bf16_t* qp) {
    float ss = 0.f;
#pragma unroll
    for (int ks = 0; ks < 2; ++ks) {
      const uint4 u = *(const uint4*)(qp + (size_t)qtok * 64 + ks * 16 + 8 * h);
      ss += bf_lo(u.x) * bf_lo(u.x) + bf_hi(u.x) * bf_hi(u.x) + bf_lo(u.y) * bf_lo(u.y) + bf_hi(u.y) * bf_hi(u.y)
          + bf_lo(u.z) * bf_lo(u.z) + bf_hi(u.z) * bf_hi(u.z) + bf_lo(u.w) * bf_lo(u.w) + bf_hi(u.w) * bf_hi(u.w);
    }
    return ss;
  };
  float qsA = sumsq(qA0), qsB = sumsq(qB1);
  if (DUAL == 1) { qsA += sumsq(qA1); qsB += sumsq(qB0); }
  qsA += xhalf(qsA); qsB += xhalf(qsB);
  const float M = fmaxf(sqrtf(qsA) * kmaxA, sqrtf(qsB) * kmaxB);
  int* flag = (int*)(smem + A_BIAS + 8192 + 16);
  if (otid() == 0) *flag = 0;
  __syncthreads();
  if (!(M < 64.f)) *flag = 1;
  __syncthreads();
  if (*flag) {
    NaInfo nz; nz.r0q = 0; nz.c0 = 0; nz.rq = 0; nz.cq = 0; nz.sb = nullptr;
    if (DUAL == 1) {
      flash_head<2, 0, false>(qA0, qA1, qA0, k0p, k1p, k0p, vt, b, qtok, 0, 32, 0.f, nz, smem, oA0, oA1, 0.f);
      flash_head<2, 0, false>(qB0, qB1, qB0, k0p, k1p, k0p, vt, b, qtok, 0, 32, 0.f, nz, smem, oB0, oB1, 0.f);
    } else {
      flash_head<1, 1, false>(qA0, qA0, qA0, k0p, k0p, k0p, vt, b, qtok, 0, 32, slope2, nz, smem, oA0, oA1, 0.f);
      flash_head<1, 1, false>(qB1, qB1, qB1, k1p, k1p, k1p, vt, b, qtok, 0, 32, slope2, nz, smem, oB0, oB1, 0.f);
    }
  }
  else if (DUAL == 2) {
    const int q0 = (qtok & (SEQ - 1)) & ~255;
    const int D = (int)(214.f / slope2) + 1;
    const int ta = max(0, (q0 - D) >> 7), tb = min(32, ((q0 + 255 + D) >> 7) + 1);
    flash_dual<DUAL, true>(qA0, qA1, qB0, qB1, k0p, k1p, vt, b, qtok, ta, tb, slope2, smem, oA0, oA1, oB0, oB1);
  } else flash_dual<DUAL, true>(qA0, qA1, qB0, qB1, k0p, k1p, vt, b, qtok, 0, 32, slope2, smem, oA0, oA1, oB0, oB1);
}


template <bool BOUND>
DI void flash_mla2(const bf16_t* q0p, const bf16_t* q1p, const bf16_t* q2p, const bf16_t* k0p, const bf16_t* k1p, const bf16_t* k2p,
                   const bf16_t* vt, int b, int qtokA, int qtokB, char* smem,
                   f32x16& oA0, f32x16& oA1, f32x16& oB0, f32x16& oB1) {
  constexpr int KSTR = 3 * 64 + 16;
  const int tid = otid(), lane = tid & 63, r = lane & 31, h = lane >> 5;
  bf16x8 qa[3][2], qb[3][2];
#pragma unroll
  for (int c = 0; c < 3; ++c) {
    const bf16_t* qp = (c == 0) ? q0p : (c == 1) ? q1p : q2p;
#pragma unroll
    for (int ks = 0; ks < 2; ++ks) {
      qa[c][ks] = *(const bf16x8*)(qp + (size_t)qtokA * 64 + ks * 16 + 8 * h);
      qb[c][ks] = *(const bf16x8*)(qp + (size_t)qtokB * 64 + ks * 16 + 8 * h);
    }
  }
  const int krow = tid >> 2, kseg = tid & 3;
  const size_t koff_g = ((size_t)b * SEQ + krow) * 64 + kseg * 8;
  const int kdst = krow * KSTR + kseg * 16;
  const int vd = tid >> 4, vseg = tid & 15;
  const bf16_t* vsrc = vt + ((size_t)b * 64 + vd) * SEQ + vseg * 8;
  const int vdst = A_VOFF + vd * V_ROW + vseg * 16;
  uint4 kr0, kr1, kr2, vr0, vr1;
  auto gload_k = [&](int t) {
    kr0 = *(const uint4*)(k0p + koff_g + (size_t)t * 128 * 64);
    kr1 = *(const uint4*)(k1p + koff_g + (size_t)t * 128 * 64);
    kr2 = *(const uint4*)(k2p + koff_g + (size_t)t * 128 * 64);
  };
  auto gload_v = [&](int t) {
    vr0 = *(const uint4*)(vsrc + t * 128);
    vr1 = *(const uint4*)(vsrc + (size_t)32 * SEQ + t * 128);
  };
  auto lstore = [&](char* st) {
    *(uint4*)(st + kdst) = kr0;
    *(uint4*)(st + kdst + 64) = kr1;
    *(uint4*)(st + kdst + 128) = kr2;
    *(uint4*)(st + vdst) = vr0;
    *(uint4*)(st + vdst + 32 * V_ROW) = vr1;
  };
  gload_k(0); gload_v(0);
  lstore(smem);
  __syncthreads();
#pragma unroll
  for (int c = 0; c < 3; ++c)
#pragma unroll
    for (int ks = 0; ks < 2; ++ks) { asm volatile("" : "+v"(qa[c][ks])); asm volatile("" : "+v"(qb[c][ks])); }
  float mA = -1e30f, lA = 0.f, mB = -1e30f, lB = 0.f;
#pragma unroll
  for (int i = 0; i < 16; ++i) { oA0[i] = 0.f; oA1[i] = 0.f; oB0[i] = 0.f; oB1[i] = 0.f; }

  auto softmax_pv = [&](const char* cur, int hf, f32x16& s0, f32x16& s1, float& m, float& l, f32x16& o0, f32x16& o1) {
    if (BOUND) {
      float ps = 0.f;
#pragma unroll
      for (int i = 0; i < 16; ++i) {
        s0[i] = fexp2(s0[i]);
        s1[i] = fexp2(s1[i]);
        ps += s0[i] + s1[i];
      }
      l += ps;
    } else {
      float mx = fmaxf(s0[0], s1[0]);
#pragma unroll
      for (int i = 1; i < 16; ++i) mx = fmaxf(mx, fmaxf(s0[i], s1[i]));
      mx = fmaxf(mx, xhalf(mx));
      const float mnew = fmaxf(m, mx);
      const float alpha = fexp2(m - mnew);
      m = mnew;
      float ps = 0.f;
#pragma unroll
      for (int i = 0; i < 16; ++i) {
        s0[i] = fexp2(s0[i] - mnew);
        s1[i] = fexp2(s1[i] - mnew);
        ps += s0[i] + s1[i];
      }
      l = l * alpha + ps;
#pragma unroll
      for (int i = 0; i < 16; ++i) { o0[i] *= alpha; o1[i] *= alpha; }
    }
    const char* vb0 = cur + A_VOFF + r * V_ROW + hf * 128 + 16 * h;
#pragma unroll
    for (int kb = 0; kb < 2; ++kb)
#pragma unroll
      for (int s = 0; s < 2; ++s) {
        uint4 pu;
        if (kb == 0) {
          pu.x = pk_bf16(s0[8 * s + 0], s0[8 * s + 1]); pu.y = pk_bf16(s0[8 * s + 2], s0[8 * s + 3]);
          pu.z = pk_bf16(s0[8 * s + 4], s0[8 * s + 5]); pu.w = pk_bf16(s0[8 * s + 6], s0[8 * s + 7]);
        } else {
          pu.x = pk_bf16(s1[8 * s + 0], s1[8 * s + 1]); pu.y = pk_bf16(s1[8 * s + 2], s1[8 * s + 3]);
          pu.z = pk_bf16(s1[8 * s + 4], s1[8 * s + 5]); pu.w = pk_bf16(s1[8 * s + 6], s1[8 * s + 7]);
        }
        const bf16x8 pf = __builtin_bit_cast(bf16x8, pu);
        const int koff = (kb * 32 + 16 * s) * 2;
        { const bf16x8 vf = *(const bf16x8*)(vb0 + koff); o0 = MFMA(vf, pf, o0); }
        { const bf16x8 vf = *(const bf16x8*)(vb0 + 32 * V_ROW + koff); o1 = MFMA(vf, pf, o1); }
      }
  };
#pragma nounroll
  for (int t = 0; t < 32; ++t) {
    const char* cur = smem + (t & 1) * A_STAGE;
    const bool more = (t + 1 < 32);
    if (more) gload_k(t + 1);
#pragma nounroll
    for (int hf = 0; hf < 2; ++hf) {
      if (hf == 1) gload_v(more ? t + 1 : t);
      const char* kb0 = cur + (hf * 64 + r) * KSTR + h * 16;
      f32x16 s0, s1;
#pragma unroll
      for (int st = 0; st < 2; ++st) {
        __builtin_amdgcn_sched_barrier(0);
#pragma unroll
        for (int i = 0; i < 16; ++i) { s0[i] = 0.f; s1[i] = 0.f; }
#pragma unroll
        for (int c = 0; c < 3; ++c) {
          bf16x8 ka[2], kb[2];
#pragma unroll
          for (int ks = 0; ks < 2; ++ks) {
            ka[ks] = *(const bf16x8*)(kb0 + c * 64 + ks * 32);
            kb[ks] = *(const bf16x8*)(kb0 + 32 * KSTR + c * 64 + ks * 32);
          }
#pragma unroll
          for (int ks = 0; ks < 2; ++ks) {
            if (st == 0) { s0 = MFMA(ka[ks], qa[c][ks], s0); s1 = MFMA(kb[ks], qa[c][ks], s1); }
            else         { s0 = MFMA(ka[ks], qb[c][ks], s0); s1 = MFMA(kb[ks], qb[c][ks], s1); }
          }
        }
        if (st == 0) softmax_pv(cur, hf, s0, s1, mA, lA, oA0, oA1);
        else         softmax_pv(cur, hf, s0, s1, mB, lB, oB0, oB1);
      }
    }
    if (more) lstore(smem + ((t + 1) & 1) * A_STAGE);
    __syncthreads();
  }
  lA += xhalf(lA); lB += xhalf(lB);
  const float ia = 1.f / lA, ib = 1.f / lB;
#pragma unroll
  for (int i = 0; i < 16; ++i) { oA0[i] *= ia; oA1[i] *= ia; oB0[i] *= ib; oB1[i] *= ib; }
}

DI void flash_mla2_auto(const bf16_t* q0p, const bf16_t* q1p, const bf16_t* q2p, const bf16_t* k0p, const bf16_t* k1p, const bf16_t* k2p,
                        const bf16_t* vt, int b, int qtokA, int qtokB, char* smem,
                        f32x16& oA0, f32x16& oA1, f32x16& oB0, f32x16& oB1, float kmax_pad) {
  const int h = (otid() & 63) >> 5;
  float qsA = 0.f, qsB = 0.f;
#pragma unroll
  for (int c = 0; c < 3; ++c) {
    const bf16_t* qp = (c == 0) ? q0p : (c == 1) ? q1p : q2p;
#pragma unroll
    for (int ks = 0; ks < 2; ++ks) {
      const uint4 u = *(const uint4*)(qp + (size_t)qtokA * 64 + ks * 16 + 8 * h);
      qsA += bf_lo(u.x) * bf_lo(u.x) + bf_hi(u.x) * bf_hi(u.x) + bf_lo(u.y) * bf_lo(u.y) + bf_hi(u.y) * bf_hi(u.y)
           + bf_lo(u.z) * bf_lo(u.z) + bf_hi(u.z) * bf_hi(u.z) + bf_lo(u.w) * bf_lo(u.w) + bf_hi(u.w) * bf_hi(u.w);
      const uint4 w = *(const uint4*)(qp + (size_t)qtokB * 64 + ks * 16 + 8 * h);
      qsB += bf_lo(w.x) * bf_lo(w.x) + bf_hi(w.x) * bf_hi(w.x) + bf_lo(w.y) * bf_lo(w.y) + bf_hi(w.y) * bf_hi(w.y)
           + bf_lo(w.z) * bf_lo(w.z) + bf_hi(w.z) * bf_hi(w.z) + bf_lo(w.w) * bf_lo(w.w) + bf_hi(w.w) * bf_hi(w.w);
    }
  }
  qsA += xhalf(qsA); qsB += xhalf(qsB);
  const float M = sqrtf(fmaxf(qsA, qsB)) * kmax_pad;
  int* flag = (int*)(smem + A_BIAS + 8192 + 16);
  if (otid() == 0) *flag = 0;
  __syncthreads();
  if (!(M < 64.f)) *flag = 1;
  __syncthreads();
  if (*flag) {
    NaInfo nz; nz.r0q = 0; nz.c0 = 0; nz.rq = 0; nz.cq = 0; nz.sb = nullptr;
    flash_head<3, 0, false>(q0p, q1p, q2p, k0p, k1p, k2p, vt, b, qtokA, 0, 32, 0.f, nz, smem, oA0, oA1, 0.f);
    flash_head<3, 0, false>(q0p, q1p, q2p, k0p, k1p, k2p, vt, b, qtokB, 0, 32, 0.f, nz, smem, oB0, oB1, 0.f);
  } else flash_mla2<true>(q0p, q1p, q2p, k0p, k1p, k2p, vt, b, qtokA, qtokB, smem, oA0, oA1, oB0, oB1);
}

DI float kmax_load(const Params& p, int layer, int b, int idx) {
  return __uint_as_float(((const unsigned*)(p.ws + OFF_KMAX))[(layer * 16 + b) * 32 + idx]);
}

constexpr int N_ITEMS_XCD = 208;

DI void store_o(bf16_t* dst  , const f32x16& o0, const f32x16& o1, int h) {
#pragma unroll
  for (int g = 0; g < 4; ++g) {
    uint2 u;
    u.x = pk_bf16(o0[4 * g], o0[4 * g + 1]); u.y = pk_bf16(o0[4 * g + 2], o0[4 * g + 3]);
    *(uint2*)(dst + 8 * g + 4 * h) = u;
    u.x = pk_bf16(o1[4 * g], o1[4 * g + 1]); u.y = pk_bf16(o1[4 * g + 2], o1[4 * g + 3]);
    *(uint2*)(dst + 32 + 8 * g + 4 * h) = u;
  }
}

DI void phase_attn(const Params& p, int layer, char* smem) {
  unsigned* ctr = (unsigned*)(p.ws + OFF_CTRL) + layer * 8;
  int qsel = 0;
  int* s_item = (int*)(smem + A_BIAS + 8192);
  float* sbias = (float*)(smem + A_BIAS);
  const bf16_t* big = (const bf16_t*)(p.ws + OFF_BIG);
  bf16_t* ocat = (bf16_t*)(p.ws + OFF_OCAT);
  NaInfo na0; na0.r0q = 0; na0.c0 = 0; na0.rq = 0; na0.cq = 0; na0.sb = sbias;
  for (;;) {
    const int tid = otid(), lane = tid & 63, wave = tid >> 6, r = lane & 31, h = lane >> 5;
    __syncthreads();
    const int xq = (blockIdx.x + qsel) & 7;
    if (tid == 0) *s_item = (int)atomicAdd(ctr + xq, 1u);
    __syncthreads();
    const int it = *s_item;
    if (it >= N_ITEMS_XCD) { if (++qsel >= 8) break; continue; }
    if (it < 16) {
      const int b = xq + 8 * ((it >> 3) & 1), q5 = it & 7;
      const int qtokA = b * SEQ + q5 * 512 + wave * 64 + r, qtokB = qtokA + 32;
      float ssqA = 0.f, ssqB = 0.f;
      for (int hd = 0; hd < 4; ++hd) {
        f32x16 o0, o1, u0, u1;
        const bf16_t* qn = big + (SL_BQN + hd) * SLOT_ELEMS;
        const bf16_t* qr = big + (SL_BQR + (hd >> 1)) * SLOT_ELEMS + (hd & 1) * 32;
        const bf16_t* kn = big + (SL_BKN + hd) * SLOT_ELEMS;
        const bf16_t* krp = big + SL_KR * SLOT_ELEMS;
        const float km = sqrtf(kmax_load(p, layer, b, KM_BN + hd) + kmax_load(p, layer, b, KM_BR)) * 1.01f;
        flash_mla2_auto(qn, qn + 32, qr, kn, kn + 32, krp, big + (SL_BV + hd) * SLOT_ELEMS, b, qtokA, qtokB, smem, o0, o1, u0, u1, km);
#pragma unroll
        for (int i = 0; i < 16; ++i) { ssqA += o0[i] * o0[i] + o1[i] * o1[i]; ssqB += u0[i] * u0[i] + u1[i] * u1[i]; }
        const int tid2 = otid(), tA = b * SEQ + q5 * 512 + (tid2 >> 6) * 64 + (tid2 & 31), h2 = (tid2 >> 5) & 1;
        store_o(ocat + (size_t)tA * 1024 + 256 + hd * 64, o0, o1, h2);
        store_o(ocat + (size_t)(tA + 32) * 1024 + 256 + hd * 64, u0, u1, h2);
      }
      ssqA += xhalf(ssqA); ssqB += xhalf(ssqB);
      const float rstdA = frsq(ssqA * (1.f / 256.f) + EPS), rstdB = frsq(ssqB * (1.f / 256.f) + EPS);
      const int tid3 = otid(), tA3 = b * SEQ + q5 * 512 + (tid3 >> 6) * 64 + (tid3 & 31), h3 = (tid3 >> 5) & 1;
#pragma unroll 4
      for (int j = 0; j < 64; ++j) {
        const int tk = (j < 32) ? tA3 : tA3 + 32;
        const float rs = (j < 32) ? rstdA : rstdB;
        uint2* a = (uint2*)(ocat + (size_t)tk * 1024 + 256 + 8 * (j & 31) + 4 * h3);
        uint2 u = *a;
        u.x = pk_bf16(bf_lo(u.x) * rs, bf_hi(u.x) * rs);
        u.y = pk_bf16(bf_lo(u.y) * rs, bf_hi(u.y) * rs);
        *a = u;
      }
    } else if (it < 48) {
      const int x = it - 16;
      const int b = xq + 8 * ((x >> 4) & 1), qb = x & 15;
      const int qtok = b * SEQ + qb * 256 + wave * 32 + r;
      float ssq = 0.f;
      for (int pr = 0; pr < 2; ++pr) {
        f32x16 o0, o1, u0, u1;
        const bf16_t* qa = big + (SL_AQ + 2 * pr) * SLOT_ELEMS;
        const bf16_t* qb2 = big + (SL_AQ + 2 * pr + 1) * SLOT_ELEMS;
        const bf16_t* k = big + (SL_AK + pr) * SLOT_ELEMS;
        const float km = sqrtf(kmax_load(p, layer, b, KM_A + pr)) * 1.01f;
        flash_dual_auto<1>(qa, qa + 32, qb2, qb2 + 32, k, k + 32, big + (SL_AV + pr) * SLOT_ELEMS, b, qtok, 0.f, smem, o0, o1, u0, u1, km, km);
#pragma unroll
        for (int i = 0; i < 16; ++i) ssq += o0[i] * o0[i] + o1[i] * o1[i] + u0[i] * u0[i] + u1[i] * u1[i];
        const int tid2 = otid(), qtok2 = b * SEQ + qb * 256 + (tid2 >> 6) * 32 + (tid2 & 31), h2 = (tid2 >> 5) & 1;
        store_o(ocat + (size_t)qtok2 * 1024 + (2 * pr) * 64, o0, o1, h2);
        store_o(ocat + (size_t)qtok2 * 1024 + (2 * pr + 1) * 64, u0, u1, h2);
      }
      ssq += xhalf(ssq);
      const float rstd = frsq(ssq * (1.f / 256.f) + EPS);
#pragma unroll
      for (int j = 0; j < 32; ++j) {
        uint2* a = (uint2*)(ocat + (size_t)qtok * 1024 + 8 * j + 4 * h);
        uint2 u = *a;
        u.x = pk_bf16(bf_lo(u.x) * rstd, bf_hi(u.x) * rstd);
        u.y = pk_bf16(bf_lo(u.y) * rstd, bf_hi(u.y) * rstd);
        *a = u;
      }
    } else if (it < 144 || it >= 176) {
      int hd, bsel, qb;
      if (it < 112) { const int x = it - 48; hd = 3 - (x >> 5); bsel = (x >> 4) & 1; qb = x & 15; }
      else if (it < 144) { const int x = it - 112; hd = 1; bsel = x >> 4; qb = x & 15; }
      else { const int x = it - 176; hd = 0; bsel = x >> 4; qb = x & 15; }
      const int b = xq + 8 * bsel;
      const int qtok = b * SEQ + qb * 256 + wave * 32 + r;
      const float li = ((const float*)(p.ws + OFF_CTRL))[16 + layer * 2 + 1];
      const float lam = ((const float*)(p.ws + OFF_CTRL))[16 + layer * 2];
      const float slope2 = exp2f(-2.f * (float)(hd + 1)) * LOG2E;
      const bf16_t* q = big + (SL_CQ + hd) * SLOT_ELEMS;
      const bf16_t* k = big + (SL_CK + hd) * SLOT_ELEMS;
      const bf16_t* v = big + (SL_CV + hd) * SLOT_ELEMS;
      f32x16 a0, a1, c0, c1;
      const float km0 = sqrtf(kmax_load(p, layer, b, KM_C + hd * 2)) * 1.01f, km1 = sqrtf(kmax_load(p, layer, b, KM_C + hd * 2 + 1)) * 1.01f;
      flash_dual_auto<2>(q, q, q + 32, q + 32, k, k + 32, v, b, qtok, slope2, smem, a0, a1, c0, c1, km0, km1);
      float ssq = 0.f;
#pragma unroll
      for (int i = 0; i < 16; ++i) {
        a0[i] -= lam * c0[i]; a1[i] -= lam * c1[i];
        ssq += a0[i] * a0[i] + a1[i] * a1[i];
      }
      ssq += xhalf(ssq);
      const float rstd = frsq(ssq * (1.f / 64.f) + EPS) * (1.f - li);
      const float* gc = p.in[I_GC] + layer * 64;
#pragma unroll
      for (int i = 0; i < 16; ++i) {
        a0[i] *= rstd * gc[crow(i, h)];
        a1[i] *= rstd * gc[32 + crow(i, h)];
      }
      store_o(ocat + (size_t)qtok * 1024 + 512 + hd * 64, a0, a1, h);
    } else {
      const int x = it - 144, b = xq + 8 * (x >> 4), R4 = x & 15;
      const int qtok = b * SEQ + R4 * 256 + wave * 32 + r;
      for (int e = tid; e < 4 * 465; e += NT) sbias[e] = p.in[I_RELB][layer * 4 * 465 + e] * LOG2E;
      NaInfo na;
      na.rq = R4 * 4 + (wave >> 1);
      na.cq = (wave & 1) * 32 + r;
      na.r0q = min(max(na.rq - 4, 0), 56);
      na.c0 = min(max(na.cq - 8, 0), 48);
      const int t0 = min(max(R4 * 4 - 4, 0), 56) >> 1, t1 = ((min(max(R4 * 4 + 3 - 4, 0), 56) + 7) >> 1) + 1;
      float ssq = 0.f;
      for (int hd = 0; hd < 4; ++hd) {
        f32x16 o0, o1;
        na.sb = sbias + hd * 465;
        const bf16_t* q = big + (SL_DQ + hd) * SLOT_ELEMS;
        const bf16_t* k = big + (SL_DK + hd) * SLOT_ELEMS;
        const float km = sqrtf(kmax_load(p, layer, b, KM_D + hd)) * 1.01f;
        const float addb = ((const float*)(p.ws + OFF_CTRL))[32 + layer * 4 + hd];
        flash_auto<2, 2>(q, q + 32, q, k, k + 32, k, big + (SL_DV + hd) * SLOT_ELEMS, b, qtok, t0, t1, 0.f, na, smem, o0, o1, km, addb);
#pragma unroll
        for (int i = 0; i < 16; ++i) ssq += o0[i] * o0[i] + o1[i] * o1[i];
        store_o(ocat + (size_t)qtok * 1024 + 768 + hd * 64, o0, o1, h);
      }
      ssq += xhalf(ssq);
      const float rstd = frsq(ssq * (1.f / 256.f) + EPS);
#pragma unroll
      for (int j = 0; j < 32; ++j) {
        uint2* a = (uint2*)(ocat + (size_t)qtok * 1024 + 768 + 8 * j + 4 * h);
        uint2 u = *a;
        u.x = pk_bf16(bf_lo(u.x) * rstd, bf_hi(u.x) * rstd);
        u.y = pk_bf16(bf_lo(u.y) * rstd, bf_hi(u.y) * rstd);
        *a = u;
      }
    }
  }
}


#define XB_TMO      128
#define XB_XCNT(j)  (256  + 64 * (j))
#define XB_XSUB(j)  (1280 + 64 * (j))
#define XB_XGEN(j)  (2304 + 64 * (j))
#define XB_TOP      3328
#define XB_TOPGEN   3392
#define XCD_BAR_WORDS 3456
#define XB_SPIN_CAP (1u << 20)
DI unsigned xb_ld(unsigned* p)              { return __hip_atomic_load(p, __ATOMIC_RELAXED, __HIP_MEMORY_SCOPE_AGENT); }
DI unsigned xb_add(unsigned* p, unsigned v) { return __hip_atomic_fetch_add(p, v, __ATOMIC_RELAXED, __HIP_MEMORY_SCOPE_AGENT); }
DI unsigned xb_xcc_id() { return (unsigned)__builtin_amdgcn_s_getreg((3 << 11) | 20) & 0xFu; }
#define XB_SPIN(cond, bar) do { unsigned _sp = 0; while (cond) { __builtin_amdgcn_s_sleep(1); \
    if ((++_sp & 255u) == 0u) { if (xb_ld(&(bar)[XB_TMO])) break; if (_sp > XB_SPIN_CAP) { atomicAdd(&(bar)[XB_TMO], 1u); break; } } } } while (0)
struct XcdBarrier { unsigned* bar; unsigned x; volatile PG8_LAS unsigned* st; };
DI XcdBarrier xcd_barrier_post(unsigned* bar, volatile PG8_LAS unsigned* st) {
  XcdBarrier b; b.bar = bar; b.x = xb_xcc_id(); b.st = st;
  if (threadIdx.x == 0) (void)xb_add(&bar[XB_XCNT(b.x)], 1u);
  return b;
}
DI void xcd_barrier_complete(unsigned* bar, unsigned x, unsigned& nloc, unsigned& nx) {
  const unsigned G = gridDim.x * gridDim.y * gridDim.z;
  unsigned sum, cnt, mine, sp = 0u;
  for (;;) {
    sum = 0u; cnt = 0u; mine = 0u;
#pragma unroll
    for (unsigned j = 0; j < 16; ++j) { const unsigned c = xb_ld(&bar[XB_XCNT(j)]); sum += c; cnt += (c > 0u) ? 1u : 0u; mine = (j == x) ? c : mine; }
    if (sum == G) break;
    __builtin_amdgcn_s_sleep(1);
    if ((++sp & 255u) == 0u) { if (xb_ld(&bar[XB_TMO])) break; if (sp > XB_SPIN_CAP) { atomicAdd(&bar[XB_TMO], 1u); break; } }
  }
  nloc = mine > 0u ? mine : 1u; nx = cnt > 0u ? cnt : 1u;
}
DI void xcd_barrier(const XcdBarrier& b) {
  asm volatile("s_waitcnt vmcnt(0)" ::: "memory");
  __syncthreads();
  if (threadIdx.x == 0) {
    unsigned* bar = b.bar;
    __builtin_amdgcn_s_waitcnt(0);
    unsigned nloc = b.st[0], nx = b.st[1];
    if (nloc == 0u) { xcd_barrier_complete(bar, b.x, nloc, nx); b.st[0] = nloc; b.st[1] = nx; }
    const unsigned old = xb_add(&bar[XB_XSUB(b.x)], 1u);
    const unsigned gen = old / nloc;
    if (old + 1u == (gen + 1u) * nloc) {
      __builtin_amdgcn_fence(__ATOMIC_RELEASE, "agent");
      asm volatile("s_waitcnt vmcnt(0)" ::: "memory");
      const unsigned og = xb_add(&bar[XB_TOP], 1u);
      const unsigned tg = og / nx;
      if (og + 1u == (tg + 1u) * nx) xb_add(&bar[XB_TOPGEN], 1u);
      else XB_SPIN(xb_ld(&bar[XB_TOPGEN]) == tg, bar);
      __builtin_amdgcn_fence(__ATOMIC_ACQUIRE, "agent");
      xb_add(&bar[XB_XGEN(b.x)], 1u);
      asm volatile("s_waitcnt vmcnt(0)" ::: "memory");
    } else {
      XB_SPIN(xb_ld(&bar[XB_XGEN(b.x)]) == gen, bar);
      __builtin_amdgcn_fence(__ATOMIC_ACQUIRE, "agent");
      asm volatile("s_waitcnt vmcnt(0)" ::: "memory");
    }
  }
  __syncthreads();
}

constexpr int N_PHASES = 17;
constexpr int LDS_MAIN = 131072;
constexpr int LDS_BYTES = LDS_MAIN + 16;

DI void run_phase(const Params& p, int ph, char* smem) {
  const bf16_t* mix = (const bf16_t*)(p.ws + OFF_MIX);
  bf16_t* act = (bf16_t*)(p.ws + OFF_ACT);
  float* rstd = (float*)(p.ws + OFF_RSTD);
  if (ph == 0) {
    phase_prep(p, smem);
    phase_resid(p.in[I_X], act, nullptr, nullptr, nullptr, rstd, true);
    return;
  }
  const int l = (ph - 1) >> 3, q = (ph - 1) & 7;
  switch (q) {
    case 0: phase_gemm8<G_IN>(p, l, smem); break;
    case 1: {
      for (int t = blockIdx.x; t < 256 * 7; t += gridDim.x) {
        if (t < 256 * 3) gemm_tile<G_UQ>(p, l, t, smem); else gemm_tile<G_UKV>(p, l, t - 256 * 3, smem);
      }
    } break;
    case 2: phase_attn(p, l, smem); break;
    case 3: phase_gemm8<G_OUT>(p, l, smem); break;
    case 4: phase_resid(nullptr, act, mix, p.in[I_NMIXPOST] + l * 1024, nullptr, rstd, true); break;
    case 5: phase_gemm8<G_UP>(p, l, smem); break;
    case 6: phase_gemm8<G_DOWN>(p, l, smem); break;
    case 7: if (l == 0) phase_resid(nullptr, act, mix, p.in[I_NMLPPOST] + l * 1024, nullptr, rstd, true);
            else phase_resid(nullptr, act, mix, p.in[I_NMLPPOST] + l * 1024, p.out, nullptr, false);
            break;
  }
}

__global__ void __launch_bounds__(NT) mega_kernel(Params p, int ph0, int ph1) {
  extern __shared__ __attribute__((aligned(16))) char smem[];
  cg::grid_group grid = cg::this_grid();
  volatile PG8_LAS unsigned* st = (volatile PG8_LAS unsigned*)(PG8_LAS unsigned char*)(smem + LDS_MAIN);
  if (threadIdx.x == 0) { st[0] = 0u; st[1] = 0u; }
  __syncthreads();
  XcdBarrier xb = xcd_barrier_post((unsigned*)(p.ws + OFF_BAR), st);
  for (int ph = ph0; ph < ph1; ++ph) {
    run_phase(p, ph, smem);
    if (ph + 1 < ph1) {
      if (ph0 < 0) grid.sync();
      xcd_barrier(xb);
    }
  }
}

extern "C" void kernel_launch(void* const* d_in, const int* in_sizes, int n_in, void* d_out, int out_size, void* d_ws, size_t ws_size,
                              hipStream_t stream) {
  static int grid_blocks = 0;
  if (!grid_blocks) {
    int dev = 0, cus = 0, per_cu = 0;
    hipGetDevice(&dev);
    hipDeviceGetAttribute(&cus, hipDeviceAttributeMultiprocessorCount, dev);
    hipFuncSetAttribute((const void*)mega_kernel, hipFuncAttributeMaxDynamicSharedMemorySize, LDS_BYTES);
    hipOccupancyMaxActiveBlocksPerMultiprocessor(&per_cu, mega_kernel, NT, LDS_BYTES);
    if (per_cu < 1) per_cu = 1;
    grid_blocks = cus * per_cu;
    if (ws_size < WS_NEED) fprintf(stderr, "workspace too small: %zu < %zu\n", ws_size, (size_t)WS_NEED);
  }
  Params p{};
  for (int i = 0; i < 24; ++i) p.in[i] = (const float*)d_in[i];
  p.out = (float*)d_out;
  p.ws = (unsigned char*)d_ws;
  hipMemsetAsync((unsigned char*)d_ws + OFF_BAR, 0, XCD_BAR_WORDS * sizeof(unsigned), stream);
#if MK_ONE_LAUNCH
  int ph0 = 0, ph1 = N_PHASES;
  void* args[] = {&p, &ph0, &ph1};
  hipError_t e = hipLaunchCooperativeKernel((const void*)mega_kernel, dim3(grid_blocks), dim3(NT), args, LDS_BYTES, stream);
  if (e != hipSuccess) fprintf(stderr, "cooperative launch failed: %s (grid %d)\n", hipGetErrorString(e), grid_blocks);
#else
  for (int ph = 0; ph < N_PHASES; ++ph)
    hipLaunchKernelGGL(mega_kernel, dim3(grid_blocks), dim3(NT), LDS_BYTES, stream, p, ph, ph + 1);
#endif
}
```

```cpp
#include <hip/hip_runtime.h>
#include <hip/hip_cooperative_groups.h>
#include <cstdio>
namespace cg = cooperative_groups;

#ifndef MK_ONE_LAUNCH
#define MK_ONE_LAUNCH 1
#endif

typedef unsigned short bf16_t;
typedef __attribute__((ext_vector_type(8))) short bf16x8;
typedef __attribute__((ext_vector_type(16))) float f32x16;
typedef __attribute__((ext_vector_type(2))) float f32x2;
typedef __attribute__((ext_vector_type(2))) __bf16 bf16x2_t;
#define DI __device__ __forceinline__
#define MFMA(a, b, c) __builtin_amdgcn_mfma_f32_32x32x16_bf16((a), (b), (c), 0, 0, 0)

constexpr int NT = 512;
constexpr int T_TOK = 65536;
constexpr int SEQ = 4096;
constexpr float EPS = 1e-6f;
constexpr float LOG2E = 1.4426950408889634f;
constexpr long SLOT_ELEMS = (long)T_TOK * 64;

constexpr size_t OFF_CTRL = 0;
constexpr size_t OFF_KMAX = 1024;
constexpr size_t OFF_BAR  = 8192;
constexpr size_t OFF_ROPE = 8192 + 16384;
constexpr size_t OFF_WIN  = OFF_ROPE + 4096ull * 16 * 8;
constexpr size_t OFF_WUQ  = OFF_WIN + 2ull * 2560 * 1024 * 2;
constexpr size_t OFF_WUKV = OFF_WUQ + 2ull * 384 * 192 * 2;
constexpr size_t OFF_WOUT = OFF_WUKV + 2ull * 512 * 128 * 2;
constexpr size_t OFF_WUP  = OFF_WOUT + 2ull * 1024 * 1024 * 2;
constexpr size_t OFF_WDN  = OFF_WUP + 2ull * 4096 * 1024 * 2;
constexpr size_t OFF_ACT  = OFF_WDN + 2ull * 1024 * 4096 * 2;
constexpr size_t OFF_MIX  = OFF_ACT + (size_t)T_TOK * 1024 * 2;
constexpr size_t OFF_OCAT = OFF_MIX + (size_t)T_TOK * 1024 * 2;
constexpr size_t OFF_SSQ  = OFF_MIX + (size_t)T_TOK * 1024 * 4;
constexpr size_t OFF_RSTD = OFF_SSQ + (size_t)T_TOK * 8 * 4;
constexpr size_t OFF_BIG  = OFF_RSTD + (size_t)T_TOK * 4;
constexpr size_t WS_NEED  = OFF_BIG + (size_t)T_TOK * 4096 * 2;

constexpr int SL_AQ = 0, SL_AK = 4, SL_CQ = 6, SL_CK = 10, SL_DQ = 14, SL_DK = 18, SL_CQL = 22, SL_CKV = 25, SL_KR = 27;
constexpr int SL_AV = 28, SL_CV = 30, SL_DV = 34, SL_BQN = 38, SL_BQR = 42, SL_BKN = 44, SL_BV = 48;

constexpr int KM_A = 0, KM_C = 2, KM_D = 10, KM_BN = 14, KM_BR = 18;

struct Params {
  const float* in[24];
  float* out;
  unsigned char* ws;
};
enum { I_X = 0, I_NMIXPRE, I_NMIXPOST, I_NMLPPRE, I_NMLPPOST, I_WIN, I_AQN, I_AKN, I_BCQN, I_BCKVN, I_WUQ, I_WUKV,
       I_LQ1, I_LK1, I_LQ2, I_LK2, I_RELB, I_GA, I_GB, I_GC, I_GD, I_WOUT, I_WUP, I_WDN };

DI unsigned pk_bf16(float a, float b) {
  f32x2 f = {a, b};
  bf16x2_t v = __builtin_convertvector(f, bf16x2_t);
  return __builtin_bit_cast(unsigned, v);
}
DI float bf_lo(unsigned u) { return __uint_as_float(u << 16); }
DI float bf_hi(unsigned u) { return __uint_as_float(u & 0xffff0000u); }
DI float fexp2(float x) { return __builtin_amdgcn_exp2f(x); }
DI float frsq(float x) { return __builtin_amdgcn_rsqf(x); }
DI int crow(int i, int h) { return (i & 3) + 8 * (i >> 2) + 4 * h; }
DI float xhalf(float v) { return __shfl_xor(v, 32); }
DI void atomic_max_pos(unsigned* a, float v) { atomicMax(a, __float_as_uint(v)); }
DI int otid() { int t = threadIdx.x; asm volatile("" : "+v"(t)); return t; }

DI int win_src_col(int n) {
  const int j = n >> 6, c = n & 63;
  if (j < 4) return j * 64 + c;
  if (j < 6) return 256 + (j - 4) * 64 + c;
  if (j < 10) return 864 + (j - 6) * 64 + c;
  if (j < 14) return 1120 + (j - 10) * 64 + c;
  if (j < 18) return 1632 + (j - 14) * 64 + c;
  if (j < 22) return 1888 + (j - 18) * 64 + c;
  if (j < 25) return 512 + (j - 22) * 64 + c;
  if (j < 27) return 704 + (j - 25) * 64 + c;
  if (j == 27) return c < 32 ? 832 + c : -1;
  if (j < 30) return 384 + (j - 28) * 64 + c;
  if (j < 34) return 1376 + (j - 30) * 64 + c;
  if (j < 38) return 2144 + (j - 34) * 64 + c;
  return -1;
}
DI int wuq_src_col(int n) {
  const int j = n >> 6, c = n & 63;
  if (j < 4) return j * 96 + c;
  const int hh = (j - 4) * 2 + (c >> 5);
  return hh * 96 + 64 + (c & 31);
}
DI int wukv_src_col(int n) {
  const int j = n >> 6, c = n & 63;
  if (j < 4) return j * 128 + c;
  return (j - 4) * 128 + 64 + c;
}

template <int WID>
DI void convert_weight(const Params& p, int layer, float* tile  ) {
  constexpr int K = (WID == 0) ? 1024 : (WID == 1) ? 192 : (WID == 2) ? 128 : (WID == 3) ? 1024 : (WID == 4) ? 1024 : 4096;
  constexpr int NS = (WID == 0) ? 2400 : (WID == 1) ? 384 : (WID == 2) ? 512 : (WID == 3) ? 1024 : (WID == 4) ? 4096 : 1024;
  constexpr int ND = (WID == 0) ? 2560 : NS;
  constexpr int IIN = (WID == 0) ? I_WIN : (WID == 1) ? I_WUQ : (WID == 2) ? I_WUKV : (WID == 3) ? I_WOUT : (WID == 4) ? I_WUP : I_WDN;
  constexpr size_t OFF = (WID == 0) ? OFF_WIN : (WID == 1) ? OFF_WUQ : (WID == 2) ? OFF_WUKV : (WID == 3) ? OFF_WOUT : (WID == 4) ? OFF_WUP : OFF_WDN;
  const float* src = p.in[IIN] + (size_t)layer * K * NS;
  bf16_t* dst = (bf16_t*)(p.ws + OFF) + (size_t)layer * ND * K;
  constexpr int TK = K / 64, TN = ND / 64;
  const int tid = otid();
  for (int t = blockIdx.x; t < TK * TN; t += gridDim.x) {
    const int k0 = (t % TK) * 64, n0 = (t / TK) * 64;
    __syncthreads();
#pragma unroll
    for (int j = 0; j < 8; ++j) {
      const int kk = (tid >> 6) + 8 * j, nn = tid & 63;
      const int n = n0 + nn, k = k0 + kk;
      int sc;
      if (WID == 0) sc = win_src_col(n); else if (WID == 1) sc = wuq_src_col(n); else if (WID == 2) sc = wukv_src_col(n); else sc = n;
      float v = 0.f;
      if (sc >= 0) {
        v = src[(size_t)k * NS + sc];
        float g = 1.f;
        if (WID == 0) g = p.in[I_NMIXPRE][layer * 1024 + k];
        else if (WID == 1) g = p.in[I_BCQN][layer * 192 + k];
        else if (WID == 2) g = p.in[I_BCKVN][layer * 128 + k];
        else if (WID == 3) g = (k < 256) ? p.in[I_GA][layer * 256 + k] : (k < 512) ? p.in[I_GB][layer * 256 + k - 256] : (k < 768) ? 1.f : p.in[I_GD][layer * 256 + k - 768];
        else if (WID == 4) g = p.in[I_NMLPPRE][layer * 1024 + k];
        v *= g;
      }
      tile[kk * 65 + nn] = v;
    }
    __syncthreads();
#pragma unroll
    for (int j = 0; j < 4; ++j) {
      const int nn = (tid >> 5) + 16 * j, kk2 = (tid & 31) * 2;
      const unsigned u = pk_bf16(tile[kk2 * 65 + nn], tile[(kk2 + 1) * 65 + nn]);
      *(unsigned*)(dst + (size_t)(n0 + nn) * K + k0 + kk2) = u;
    }
  }
}

DI void phase_prep(const Params& p, char* smem) {
  const int tid = otid();
  if (blockIdx.x == 0 && tid < 16) atomicExch((unsigned*)(p.ws + OFF_CTRL) + tid, 0u);
  if (blockIdx.x == 2 && tid < 8) {
    const float* rb = p.in[I_RELB] + tid * 465;
    float mx = 0.f;
    for (int i = 0; i < 465; ++i) mx = fmaxf(mx, fabsf(rb[i]));
    ((float*)(p.ws + OFF_CTRL))[32 + tid] = mx * LOG2E;
  }
  if (blockIdx.x == 1) { atomicExch((unsigned*)(p.ws + OFF_KMAX) + tid, 0u); atomicExch((unsigned*)(p.ws + OFF_KMAX) + 512 + tid, 0u); }
  if (blockIdx.x == 0 && tid >= 64 && tid < 66) {
    const int l = tid - 64;
    float d1 = 0.f, d2 = 0.f;
    for (int i = 0; i < 32; ++i) {
      d1 += p.in[I_LQ1][l * 32 + i] * p.in[I_LK1][l * 32 + i];
      d2 += p.in[I_LQ2][l * 32 + i] * p.in[I_LK2][l * 32 + i];
    }
    const float li = 0.8f - 0.6f * expf(-0.3f * (float)l);
    float* c = (float*)(p.ws + OFF_CTRL);
    c[16 + 2 * l] = expf(d1) - expf(d2) + li;
    c[17 + 2 * l] = li;
  }
  {
    float2* tab = (float2*)(p.ws + OFF_ROPE);
    for (int e = blockIdx.x * NT + tid; e < 4096 * 16; e += gridDim.x * NT) {
      const int pos = e >> 4, f = e & 15;
      const float inv = powf(10000.f, -(float)(2 * f) / 32.f);
      const float ang = (float)pos * inv;
      double rev = (double)ang * 0.15915494309189535;
      rev -= floor(rev);
      const float rf = (float)rev;
      tab[e] = make_float2(__builtin_amdgcn_cosf(rf), __builtin_amdgcn_sinf(rf));
    }
  }
  float* tile = (float*)smem;
  for (int l = 0; l < 2; ++l) {
    convert_weight<0>(p, l, tile);
    convert_weight<1>(p, l, tile);
    convert_weight<2>(p, l, tile);
    convert_weight<3>(p, l, tile);
    convert_weight<4>(p, l, tile);
    convert_weight<5>(p, l, tile);
  }
}

DI float wave_sum(float v) {
#pragma unroll
  for (int o = 32; o; o >>= 1) v += __shfl_xor(v, o);
  return v;
}
DI void phase_resid(const float* x_f32, bf16_t* xb, const bf16_t* y, const float* g_post, float* out_f32, float* rstd_out, bool write_xb) {
  const int lane = otid() & 63;
  const int gw = blockIdx.x * (NT / 64) + (otid() >> 6), nw = gridDim.x * (NT / 64);
  for (int row = gw; row < T_TOK; row += nw) {
    float xv[2][8];
#pragma unroll
    for (int j = 0; j < 2; ++j) {
      const size_t off = (size_t)row * 1024 + j * 512 + lane * 8;
      if (x_f32) {
        const float4 a = *(const float4*)(x_f32 + off), c = *(const float4*)(x_f32 + off + 4);
        xv[j][0] = a.x; xv[j][1] = a.y; xv[j][2] = a.z; xv[j][3] = a.w; xv[j][4] = c.x; xv[j][5] = c.y; xv[j][6] = c.z; xv[j][7] = c.w;
      } else {
        const uint4 u = *(const uint4*)(xb + off);
        xv[j][0] = bf_lo(u.x); xv[j][1] = bf_hi(u.x); xv[j][2] = bf_lo(u.y); xv[j][3] = bf_hi(u.y);
        xv[j][4] = bf_lo(u.z); xv[j][5] = bf_hi(u.z); xv[j][6] = bf_lo(u.w); xv[j][7] = bf_hi(u.w);
      }
    }
    if (y) {
      float yv[2][8];
      float ss = 0.f;
#pragma unroll
      for (int j = 0; j < 2; ++j) {
        const uint4 u = *(const uint4*)(y + (size_t)row * 1024 + j * 512 + lane * 8);
        yv[j][0] = bf_lo(u.x); yv[j][1] = bf_hi(u.x); yv[j][2] = bf_lo(u.y); yv[j][3] = bf_hi(u.y);
        yv[j][4] = bf_lo(u.z); yv[j][5] = bf_hi(u.z); yv[j][6] = bf_lo(u.w); yv[j][7] = bf_hi(u.w);
#pragma unroll
        for (int e = 0; e < 8; ++e) ss += yv[j][e] * yv[j][e];
      }
      ss = wave_sum(ss);
      const float rs = frsq(ss * (1.f / 1024.f) + EPS);
#pragma unroll
      for (int j = 0; j < 2; ++j) {
        const float4 g0 = *(const float4*)(g_post + j * 512 + lane * 8), g1 = *(const float4*)(g_post + j * 512 + lane * 8 + 4);
        xv[j][0] += yv[j][0] * rs * g0.x; xv[j][1] += yv[j][1] * rs * g0.y; xv[j][2] += yv[j][2] * rs * g0.z; xv[j][3] += yv[j][3] * rs * g0.w;
        xv[j][4] += yv[j][4] * rs * g1.x; xv[j][5] += yv[j][5] * rs * g1.y; xv[j][6] += yv[j][6] * rs * g1.z; xv[j][7] += yv[j][7] * rs * g1.w;
      }
    }
    if (out_f32) {
#pragma unroll
      for (int j = 0; j < 2; ++j) {
        const size_t off = (size_t)row * 1024 + j * 512 + lane * 8;
        *(float4*)(out_f32 + off) = make_float4(xv[j][0], xv[j][1], xv[j][2], xv[j][3]);
        *(float4*)(out_f32 + off + 4) = make_float4(xv[j][4], xv[j][5], xv[j][6], xv[j][7]);
      }
    }
    if (write_xb) {
#pragma unroll
      for (int j = 0; j < 2; ++j) {
        uint4 u;
        u.x = pk_bf16(xv[j][0], xv[j][1]); u.y = pk_bf16(xv[j][2], xv[j][3]); u.z = pk_bf16(xv[j][4], xv[j][5]); u.w = pk_bf16(xv[j][6], xv[j][7]);
        *(uint4*)(xb + (size_t)row * 1024 + j * 512 + lane * 8) = u;
      }
    }
    if (rstd_out) {
      float ss = 0.f;
#pragma unroll
      for (int j = 0; j < 2; ++j)
#pragma unroll
        for (int e = 0; e < 8; ++e) ss += xv[j][e] * xv[j][e];
      ss = wave_sum(ss);
      if (lane == 0) rstd_out[row] = frsq(ss * (1.f / 1024.f) + EPS);
    }
  }
}

constexpr int G_ROW = 144;
constexpr int G_XS = 256 * G_ROW;
constexpr int G_STAGE = 384 * G_ROW;

template <bool SWAP>
DI void gemm_mainloop(const bf16_t* __restrict__ Xb, long x_slab, int ldx, const bf16_t* __restrict__ Wb, int K, char* smem,
                      f32x16 (&acc)[2][2]) {
  const int tid = otid(), lane = tid & 63, wave = tid >> 6, r = lane & 31, h = lane >> 5;
  const int wm = wave >> 1, wn = wave & 1;
  const int nkt = K >> 6;
  const int lrow = tid >> 3, lseg = tid & 7;
  const bf16_t* xg = Xb + (long)lrow * ldx + lseg * 8;
  const bf16_t* wg = Wb + (long)lrow * K + lseg * 8;
  const int lds_off = lrow * G_ROW + lseg * 16;
  uint4 xr[4], wr[2];
#pragma unroll
  for (int j = 0; j < 4; ++j) xr[j] = *(const uint4*)(xg + (long)j * 64 * ldx);
#pragma unroll
  for (int j = 0; j < 2; ++j) wr[j] = *(const uint4*)(wg + (long)j * 64 * K);
#pragma unroll
  for (int j = 0; j < 4; ++j) *(uint4*)(smem + lds_off + j * 64 * G_ROW) = xr[j];
#pragma unroll
  for (int j = 0; j < 2; ++j) *(uint4*)(smem + G_XS + lds_off + j * 64 * G_ROW) = wr[j];
  __syncthreads();
  const int xs_off = (wm * 64 + r) * G_ROW + h * 16;
  const int ws_off = G_XS + (wn * 64 + r) * G_ROW + h * 16;
  for (int kt = 0; kt < nkt; ++kt) {
    const char* cur = smem + (kt & 1) * G_STAGE;
    char* nxt = smem + ((kt + 1) & 1) * G_STAGE;
    const bool more = (kt + 1 < nkt);
    if (more) {
      const bf16_t* xg2 = xg + (long)(kt + 1) * x_slab;
      const bf16_t* wg2 = wg + (kt + 1) * 64;
#pragma unroll
      for (int j = 0; j < 4; ++j) xr[j] = *(const uint4*)(xg2 + (long)j * 64 * ldx);
#pragma unroll
      for (int j = 0; j < 2; ++j) wr[j] = *(const uint4*)(wg2 + (long)j * 64 * K);
    }
#pragma unroll
    for (int ks = 0; ks < 4; ++ks) {
      bf16x8 xf[2], wf[2];
      xf[0] = *(const bf16x8*)(cur + xs_off + ks * 32);
      xf[1] = *(const bf16x8*)(cur + xs_off + 32 * G_ROW + ks * 32);
      wf[0] = *(const bf16x8*)(cur + ws_off + ks * 32);
      wf[1] = *(const bf16x8*)(cur + ws_off + 32 * G_ROW + ks * 32);
#pragma unroll
      for (int nb = 0; nb < 2; ++nb)
#pragma unroll
        for (int tb = 0; tb < 2; ++tb) {
          if (SWAP) acc[nb][tb] = MFMA(wf[nb], xf[tb], acc[nb][tb]);
          else      acc[nb][tb] = MFMA(xf[tb], wf[nb], acc[nb][tb]);
        }
    }
    if (more) {
#pragma unroll
      for (int j = 0; j < 4; ++j) *(uint4*)(nxt + lds_off + j * 64 * G_ROW) = xr[j];
#pragma unroll
      for (int j = 0; j < 2; ++j) *(uint4*)(nxt + G_XS + lds_off + j * 64 * G_ROW) = wr[j];
    }
    __syncthreads();
  }
}

DI void epi_slot(f32x16 (&acc)[2][2], bf16_t* dst  , int tok0  , const float* norm_gain,
                 int rope, const float2* tab, float* ssq_out, const float (&rs)[2], unsigned* kmax_out = nullptr) {
  const int lane = otid() & 63, r = lane & 31, h = lane >> 5;
  float kmx = 0.f;
#pragma unroll
  for (int tb = 0; tb < 2; ++tb) {
    const int tok = tok0 + tb * 32 + r;
    float sc = rs[tb];
    if (norm_gain || ssq_out) {
      float ss = 0.f;
#pragma unroll
      for (int nb = 0; nb < 2; ++nb)
#pragma unroll
        for (int i = 0; i < 16; ++i) ss += acc[nb][tb][i] * acc[nb][tb][i];
      ss += xhalf(ss);
      if (ssq_out && h == 0) ssq_out[(size_t)tok * 8] = ss;
      if (norm_gain) {
        const float rstd = frsq(ss * (1.f / 64.f) + EPS);
#pragma unroll
        for (int nb = 0; nb < 2; ++nb)
#pragma unroll
          for (int i = 0; i < 16; ++i) acc[nb][tb][i] *= rstd * norm_gain[nb * 32 + crow(i, h)];
      }
    }
    if (rope) {
      const int s = tok & (SEQ - 1);
#pragma unroll
      for (int nb = 0; nb < 2; ++nb) {
        const int pos = (rope == 2) ? s : (nb == 0 ? (s >> 6) : (s & 63));
        const float2* tp = tab + pos * 16;
#pragma unroll
        for (int i = 0; i < 8; ++i) {
          const float2 cs = tp[crow(i, h)];
          const float x1 = acc[nb][tb][i], x2 = acc[nb][tb][i + 8];
          acc[nb][tb][i] = x1 * cs.x - x2 * cs.y;
          acc[nb][tb][i + 8] = x1 * cs.y + x2 * cs.x;
        }
      }
    }
#pragma unroll
    for (int nb = 0; nb < 2; ++nb)
#pragma unroll
      for (int g = 0; g < 4; ++g) {
        uint2 u;
        u.x = pk_bf16(acc[nb][tb][4 * g] * sc, acc[nb][tb][4 * g + 1] * sc);
        u.y = pk_bf16(acc[nb][tb][4 * g + 2] * sc, acc[nb][tb][4 * g + 3] * sc);
        *(uint2*)(dst + (size_t)tok * 64 + nb * 32 + 8 * g + 4 * h) = u;
      }
    if (kmax_out) {
      float ss = 0.f;
#pragma unroll
      for (int nb = 0; nb < 2; ++nb)
#pragma unroll
        for (int i = 0; i < 16; ++i) ss += acc[nb][tb][i] * acc[nb][tb][i];
      ss += xhalf(ss);
      kmx = fmaxf(kmx, ss * sc * sc);
    }
  }
  if (kmax_out) {
#pragma unroll
    for (int o = 1; o < 32; o <<= 1) kmx = fmaxf(kmx, __shfl_xor(kmx, o));
    if (lane == 0) atomic_max_pos(kmax_out, kmx);
  }
}

DI void epi_vt(f32x16 (&acc)[2][2], bf16_t* dst  , int tok0, const float* ssq) {
  const int lane = otid() & 63, r = lane & 31, h = lane >> 5;
  const int b = tok0 >> 12, s0 = tok0 & (SEQ - 1);
#pragma unroll
  for (int tb = 0; tb < 2; ++tb) {
    if (ssq) {
#pragma unroll
      for (int i = 0; i < 16; ++i) {
        const float* q = ssq + (size_t)(tok0 + tb * 32 + crow(i, h)) * 8;
        const float rstd = frsq((q[3] + q[4]) * (1.f / 128.f) + EPS);
        acc[0][tb][i] *= rstd;
        acc[1][tb][i] *= rstd;
      }
    }
#pragma unroll
    for (int nb = 0; nb < 2; ++nb)
#pragma unroll
      for (int g = 0; g < 4; ++g) {
        uint2 u;
        u.x = pk_bf16(acc[nb][tb][4 * g], acc[nb][tb][4 * g + 1]);
        u.y = pk_bf16(acc[nb][tb][4 * g + 2], acc[nb][tb][4 * g + 3]);
        *(uint2*)(dst + ((size_t)(b * 64 + nb * 32 + r)) * SEQ + s0 + tb * 32 + (g >> 1) * 16 + h * 8 + (g & 1) * 4) = u;
      }
  }
}

DI void zero_acc(f32x16 (&acc)[2][2]) {
#pragma unroll
  for (int a = 0; a < 2; ++a)
#pragma unroll
    for (int b = 0; b < 2; ++b)
#pragma unroll
      for (int i = 0; i < 16; ++i) acc[a][b][i] = 0.f;
}

enum { G_IN = 0, G_UQ, G_UKV, G_OUT, G_UP, G_DOWN };

template <int G>
DI void gemm_tile(const Params& p, int layer, int tile, char* smem) {
  constexpr int K = (G == G_IN) ? 1024 : (G == G_UQ) ? 192 : (G == G_UKV) ? 128 : (G == G_OUT) ? 1024 : (G == G_UP) ? 1024 : 4096;
  constexpr int NTL = (G == G_IN) ? 19 : (G == G_UQ) ? 3 : (G == G_UKV) ? 4 : (G == G_OUT) ? 8 : (G == G_UP) ? 32 : 8;
  constexpr size_t WOFF = (G == G_IN) ? OFF_WIN : (G == G_UQ) ? OFF_WUQ : (G == G_UKV) ? OFF_WUKV : (G == G_OUT) ? OFF_WOUT : (G == G_UP) ? OFF_WUP : OFF_WDN;
  const int nt = tile % NTL, mt = tile / NTL;
  const int m0 = mt * 256, n0 = nt * 128;
  const int lane = otid() & 63, wave = otid() >> 6, r = lane & 31, h = lane >> 5;
  const int wm = wave >> 1, wn = wave & 1;
  bf16_t* big = (bf16_t*)(p.ws + OFF_BIG);
  const bf16_t* W = (const bf16_t*)(p.ws + WOFF) + (size_t)layer * (NTL * 128) * K + (size_t)n0 * K;
  const bf16_t* X; long x_slab; int ldx;
  if (G == G_IN || G == G_OUT || G == G_UP) { X = (const bf16_t*)(p.ws + OFF_ACT) + (size_t)m0 * 1024; x_slab = 64; ldx = 1024; }
  else if (G == G_DOWN) { X = big + (size_t)m0 * 4096; x_slab = 64; ldx = 4096; }
  else if (G == G_UQ) { X = big + SL_CQL * SLOT_ELEMS + (size_t)m0 * 64; x_slab = SLOT_ELEMS; ldx = 64; }
  else { X = big + SL_CKV * SLOT_ELEMS + (size_t)m0 * 64; x_slab = SLOT_ELEMS; ldx = 64; }
  const bool vt_tile = (G == G_IN && nt >= 14) || (G == G_UKV && nt >= 2);
  f32x16 acc[2][2];
  zero_acc(acc);
  const int tok0 = m0 + wm * 64;
  const float2* tab = (const float2*)(p.ws + OFF_ROPE);
  float* ssq = (float*)(p.ws + OFF_SSQ);
  if (vt_tile) {
    gemm_mainloop<false>(X, x_slab, ldx, W, K, smem, acc);
    if (G == G_IN) {
      const int slot = nt * 2 + wn;
      epi_vt(acc, big + slot * SLOT_ELEMS, tok0, nullptr);
    } else {
      const int slot = SL_BV + (nt - 2) * 2 + wn;
      epi_vt(acc, big + slot * SLOT_ELEMS, tok0, ssq);
    }
    return;
  }
  gemm_mainloop<true>(X, x_slab, ldx, W, K, smem, acc);
  if (G == G_IN) {
    const int slot = nt * 2 + wn;
    float rs[2] = {1.f, 1.f};
    const float* gain = nullptr; int rope = 0; float* so = nullptr;
    if (slot < 4) { gain = p.in[I_AQN] + layer * 64; rope = 1; rs[0] = rs[1] = 0.125f * LOG2E; }
    else if (slot < 6) { gain = p.in[I_AKN] + layer * 64; rope = 1; }
    else if (slot < 10) { rs[0] = rs[1] = 0.17677669529663687f * LOG2E; }
    else if (slot < 14) { }
    else if (slot < 18) { rs[0] = rs[1] = 0.125f * LOG2E; }
    else if (slot < 22) { }
    else if (slot < 27) { so = ssq + (slot - 22); }
    else { rope = 2; }
    epi_slot(acc, big + slot * SLOT_ELEMS, tok0, gain, rope, tab, so, rs);
  } else if (G == G_UQ) {
    const int slot = (nt < 2) ? SL_BQN + nt * 2 + wn : SL_BQR + wn;
    float rs[2];
#pragma unroll
    for (int tb = 0; tb < 2; ++tb) {
      const float* q = ssq + (size_t)(tok0 + tb * 32 + r) * 8;
      rs[tb] = frsq((q[0] + q[1] + q[2]) * (1.f / 192.f) + EPS) * (0.10206207261596575f * LOG2E);
    }
    epi_slot(acc, big + slot * SLOT_ELEMS, tok0, nullptr, (nt < 2) ? 0 : 2, tab, nullptr, rs);
  } else if (G == G_UKV) {
    const int slot = SL_BKN + nt * 2 + wn;
    float rs[2];
#pragma unroll
    for (int tb = 0; tb < 2; ++tb) {
      const float* q = ssq + (size_t)(tok0 + tb * 32 + r) * 8;
      rs[tb] = frsq((q[3] + q[4]) * (1.f / 128.f) + EPS);
    }
    epi_slot(acc, big + slot * SLOT_ELEMS, tok0, nullptr, 0, tab, nullptr, rs,
             (unsigned*)(p.ws + OFF_KMAX) + (layer * 16 + (tok0 >> 12)) * 32 + KM_BN + nt * 2 + wn);
  } else if (G == G_OUT || G == G_DOWN) {
    float* out = (float*)(p.ws + OFF_MIX);
#pragma unroll
    for (int tb = 0; tb < 2; ++tb)
#pragma unroll
      for (int nb = 0; nb < 2; ++nb)
#pragma unroll
        for (int g = 0; g < 4; ++g) {
          float4 v = make_float4(acc[nb][tb][4 * g], acc[nb][tb][4 * g + 1], acc[nb][tb][4 * g + 2], acc[nb][tb][4 * g + 3]);
          *(float4*)(out + (size_t)(tok0 + tb * 32 + r) * 1024 + n0 + wn * 64 + nb * 32 + 8 * g + 4 * h) = v;
        }
  } else {
#pragma unroll
    for (int tb = 0; tb < 2; ++tb)
#pragma unroll
      for (int nb = 0; nb < 2; ++nb)
#pragma unroll
        for (int g = 0; g < 4; ++g) {
          float v0 = fmaxf(acc[nb][tb][4 * g], 0.f), v1 = fmaxf(acc[nb][tb][4 * g + 1], 0.f);
          float v2 = fmaxf(acc[nb][tb][4 * g + 2], 0.f), v3 = fmaxf(acc[nb][tb][4 * g + 3], 0.f);
          uint2 u;
          u.x = pk_bf16(v0 * v0, v1 * v1);
          u.y = pk_bf16(v2 * v2, v3 * v3);
          *(uint2*)(big + (size_t)(tok0 + tb * 32 + r) * 4096 + n0 + wn * 64 + nb * 32 + 8 * g + 4 * h) = u;
        }
  }
}


namespace pg8 {
#define PG8_LAS __attribute__((address_space(3)))
typedef float f32x4 __attribute__((ext_vector_type(4)));
typedef unsigned u32x4 __attribute__((ext_vector_type(4)));
constexpr int BM = 256, BK = 64, HALF = 128, HTB = HALF * BK * 2, STAGE_BYTES = 8 * HTB, NXCD = 8, WGM = 8;
DI int lds_byte(int r, int c) { const int st = (r >> 4) * 2 + (c >> 5), rr = r & 15, cc = c & 31, ob = rr * 64 + cc * 2; return st * 1024 + (ob ^ (((ob >> 9) & 1) << 5)); }
DI void stage_rc(int b, int& R, int& C) { const int st = b / 1024, sb = b % 1024, swz = sb ^ (((sb >> 9) & 1) << 5); R = (st >> 1) * 16 + swz / 64; C = (st & 1) * 32 + (swz % 64) / 2; }
DI int perm32(int rho) { const int n = rho >> 4, i = rho & 15; return 8 * (i >> 2) + 4 * n + (i & 3); }
struct Unit { int pm, pn; };
struct Gemm { const bf16_t* A; const bf16_t* Bt; int M, N, K; int ktm = 0; };
struct StaticOrder {
  int nM, nN, nwg, G, c, rev;
  DI void init(int M, int N, int G_, int c_, int rev_ = 0) { nM = M / BM; nN = N / BM; nwg = nM * nN; G = G_; c = c_; rev = rev_; }
  DI bool next(int i, Unit& u) const {
    const int cntu = (c < nwg) ? (nwg - c + G - 1) / G : 0;
    if (i >= cntu) return false;
    const long L = (long)(rev ? cntu - 1 - i : i) * G + c;
    int wgid = (int)L; { const int q = nwg / NXCD, r = nwg % NXCD, xcd = wgid % NXCD, off = wgid / NXCD; wgid = (xcd < r ? xcd * (q + 1) : r * (q + 1) + (xcd - r) * q) + off; }
    const int nig = WGM * nN, gid = wgid / nig, fm = gid * WGM, gsz = (nM - fm) < WGM ? (nM - fm) : WGM;
    u.pm = fm + ((wgid % nig) % gsz); u.pn = (wgid % nig) / gsz; return true;
  }
};

template <class Epi>
DI void gemm_phase(PG8_LAS unsigned char* lds, const Gemm g, const StaticOrder& S, const Epi& E) {
  const int tid = otid(), wid = __builtin_amdgcn_readfirstlane(tid >> 6), lane = tid & 63, wr = wid >> 2, wc = wid & 3, fr = lane & 15, fq = lane >> 4;
  const int K = g.K, nt = K / BK;
  unsigned voffA[2], voffB[2];
#pragma unroll
  for (int i = 0; i < 2; ++i) { int R, C; stage_rc(tid * 16 + i * 8192, R, C);
    const int Rb = ((R >> 5) << 6) + (Epi::BMAP ? perm32(R & 31) : (R & 31));
    voffA[i] = (unsigned)(R * (g.ktm ? 64 : K) + C) * 2u; voffB[i] = (unsigned)(Rb * K + C) * 2u; }
  const size_t kstep = (size_t)(BK * 2);
  const size_t hstep = (size_t)HALF * K * 2;
  const size_t hstepB = (size_t)32 * K * 2;
  const size_t tstep = 2 * hstep;
  const size_t kstepA = g.ktm ? (size_t)256 * 64 * 2 : kstep;
  const size_t hstepA = g.ktm ? (size_t)HALF * 64 * 2 : hstep;
  const size_t tstepA = g.ktm ? (size_t)(K / 64) * 256 * 64 * 2 : tstep;
  const unsigned ldsw = (unsigned)wid * 1024u;
  const int aoff = lds_byte(wr * 64 + fr, fq * 8), boff = lds_byte(wc * 32 + fr, fq * 8);
#define PG8_SA(b, h) (((b) * 2 + (h)) * HTB)
#define PG8_SB(b, h) ((4 + (b) * 2 + (h)) * HTB)
#define PG8_STAGE(bufoff, gbase, voff) do { _Pragma("unroll") for (int _i = 0; _i < 2; ++_i) \
    __builtin_amdgcn_global_load_lds((const unsigned*)((const char*)(gbase) + (voff)[_i]), (PG8_LAS unsigned*)(lds + (bufoff) + ldsw + _i * 8192), 16, 0, 0); } while (0)
#define PG8_LDA(dst, b, h) do { _Pragma("unroll") for (int m = 0; m < 4; ++m) _Pragma("unroll") for (int k = 0; k < 2; ++k) dst[m][k] = *(const PG8_LAS bf16x8*)(lds + PG8_SA(b, h) + aoff + m * 2048 + k * 1024); } while (0)
#define PG8_LDB(dst, b, h) do { _Pragma("unroll") for (int n = 0; n < 2; ++n) _Pragma("unroll") for (int k = 0; k < 2; ++k) dst[n][k] = *(const PG8_LAS bf16x8*)(lds + PG8_SB(b, h) + boff + n * 2048 + k * 1024); } while (0)
#define PG8_MMA(ai, bj, At, Bt) do { __builtin_amdgcn_s_setprio(1); _Pragma("unroll") for (int m = 0; m < 4; ++m) _Pragma("unroll") for (int n = 0; n < 2; ++n) _Pragma("unroll") for (int k = 0; k < 2; ++k) \
    acc[ai][bj][m][n] = __builtin_amdgcn_mfma_f32_16x16x32_bf16(Bt[n][k], At[m][k], acc[ai][bj][m][n], 0, 0, 0); __builtin_amdgcn_s_setprio(0); } while (0)
#define PG8_WAIT_V(n) asm volatile("s_waitcnt vmcnt(" #n ")" ::: "memory")
#define PG8_WAIT_L(n) asm volatile("s_waitcnt lgkmcnt(" #n ")" ::: "memory")
#define PG8_BAR __builtin_amdgcn_s_barrier()
#define PG8_SCHED __builtin_amdgcn_sched_barrier(0)
  Unit cur, nxt; int ui = 0;
  if (!S.next(0, cur)) return;
  f32x4 acc[2][2][4][2];
#pragma unroll
  for (int a = 0; a < 2; ++a)
#pragma unroll
    for (int b = 0; b < 2; ++b)
#pragma unroll
      for (int m = 0; m < 4; ++m)
#pragma unroll
        for (int n = 0; n < 2; ++n) acc[a][b][m][n] = (f32x4){0.f, 0.f, 0.f, 0.f};
  bf16x8 At[4][2], B0[2][2], B1[2][2];
  const char* cA = (const char*)g.A + (size_t)cur.pm * tstepA; const char* cB = (const char*)g.Bt + (size_t)cur.pn * tstep;
  PG8_STAGE(PG8_SB(0, 0), cB, voffB); PG8_STAGE(PG8_SA(0, 0), cA, voffA); PG8_STAGE(PG8_SB(0, 1), cB + hstepB, voffB); PG8_STAGE(PG8_SA(0, 1), cA + hstepA, voffA);
  if (wr == 1) PG8_BAR;
  PG8_WAIT_V(4); PG8_BAR;
  PG8_STAGE(PG8_SB(1, 0), cB + kstep, voffB); PG8_STAGE(PG8_SA(1, 0), cA + kstepA, voffA); PG8_STAGE(PG8_SB(1, 1), cB + hstepB + kstep, voffB);
  PG8_WAIT_V(6); PG8_BAR;
  for (;;) {
    const bool has_next = S.next(ui + 1, nxt);
    const char* nA = has_next ? (const char*)g.A + (size_t)nxt.pm * tstepA : cA; const char* nB = has_next ? (const char*)g.Bt + (size_t)nxt.pn * tstep : cB;
    for (int t = 0; t < nt; t += 2) {
      const bool last = (t == nt - 2);
      const char* a1 = cA + (size_t)(t + 1) * kstepA;
      const char* a2 = last ? nA : cA + (size_t)(t + 2) * kstepA; const char* b2 = last ? nB : cB + (size_t)(t + 2) * kstep;
      const char* a3 = a2 + kstepA; const char* b3 = b2 + kstep;
      PG8_LDB(B0, 0, 0); PG8_SCHED; PG8_LDA(At, 0, 0); PG8_STAGE(PG8_SA(1, 1), a1 + hstepA, voffA);
      PG8_WAIT_L(8); PG8_BAR; PG8_WAIT_L(0); PG8_MMA(0, 0, At, B0); PG8_BAR; PG8_SCHED;
      PG8_LDB(B1, 0, 1); PG8_STAGE(PG8_SB(0, 0), b2, voffB);
      PG8_BAR; PG8_WAIT_L(0); PG8_MMA(0, 1, At, B1); PG8_BAR;
      PG8_LDA(At, 0, 1); PG8_STAGE(PG8_SA(0, 0), a2, voffA);
      PG8_BAR; PG8_WAIT_L(0); PG8_MMA(1, 0, At, B0); PG8_BAR; PG8_SCHED;
      PG8_STAGE(PG8_SB(0, 1), b2 + hstepB, voffB);
      PG8_WAIT_V(6); PG8_BAR; PG8_MMA(1, 1, At, B1); PG8_BAR;
      PG8_LDB(B0, 1, 0); PG8_SCHED; PG8_LDA(At, 1, 0); PG8_STAGE(PG8_SA(0, 1), a2 + hstepA, voffA);
      PG8_WAIT_L(8); PG8_BAR; PG8_WAIT_L(0); PG8_MMA(0, 0, At, B0); PG8_BAR; PG8_SCHED;
      PG8_LDB(B1, 1, 1); PG8_STAGE(PG8_SB(1, 0), b3, voffB);
      PG8_BAR; PG8_WAIT_L(0); PG8_MMA(0, 1, At, B1); PG8_BAR;
      PG8_LDA(At, 1, 1); PG8_STAGE(PG8_SA(1, 0), a3, voffA);
      PG8_BAR; PG8_WAIT_L(0); PG8_MMA(1, 0, At, B0); PG8_BAR; PG8_SCHED;
      PG8_STAGE(PG8_SB(1, 1), b3 + hstepB, voffB);
      PG8_WAIT_V(6); PG8_BAR; PG8_MMA(1, 1, At, B1); PG8_BAR;
    }
    E(acc, cur, wr, wc, fr, fq);
    if (!has_next) break;
#pragma unroll
    for (int a = 0; a < 2; ++a)
#pragma unroll
      for (int b = 0; b < 2; ++b)
#pragma unroll
        for (int m = 0; m < 4; ++m)
#pragma unroll
          for (int n = 0; n < 2; ++n) acc[a][b][m][n] = (f32x4){0.f, 0.f, 0.f, 0.f};
    cur = nxt; cA = nA; cB = nB; ++ui;
  }
  PG8_WAIT_V(0);
  if (wr == 0) PG8_BAR;
  PG8_BAR;
#undef PG8_SA
#undef PG8_SB
#undef PG8_STAGE
#undef PG8_LDA
#undef PG8_LDB
#undef PG8_MMA
#undef PG8_WAIT_V
#undef PG8_WAIT_L
#undef PG8_BAR
#undef PG8_SCHED
}

struct EpiIn {
  static constexpr int BMAP = 0;
  const Params* p; int layer; const float* rstd;
  DI void operator()(const f32x4 (&acc)[2][2][4][2], const Unit& u, int wr, int wc, int fr, int fq) const {
    const int slot = 4 * u.pn + wc;
    bf16_t* dst = (bf16_t*)(p->ws + OFF_BIG) + (size_t)slot * SLOT_ELEMS;
    const float2* tab = (const float2*)(p->ws + OFF_ROPE);
    float* ssq_out = nullptr; const float* gain = nullptr; int rope = 0; float scale = 1.f;
    if (slot < 4) { gain = p->in[I_AQN] + layer * 64; rope = 1; scale = 0.125f * LOG2E; }
    else if (slot < 6) { gain = p->in[I_AKN] + layer * 64; rope = 1; }
    else if (slot < 10) { scale = 0.17677669529663687f * LOG2E; }
    else if (slot < 14) { }
    else if (slot < 18) { scale = 0.125f * LOG2E; }
    else if (slot < 22) { }
    else if (slot < 27) { ssq_out = (float*)(p->ws + OFF_SSQ) + (slot - 22); }
    else { rope = 2; }
    const bool is_k = (slot == 4) || (slot == 5) || (slot >= 10 && slot < 14) || (slot >= 18 && slot < 22) || (slot == 27);
    float kmx0 = 0.f, kmx1 = 0.f;
    float gv[2][2][4];
    if (gain) {
#pragma unroll
      for (int bj = 0; bj < 2; ++bj)
#pragma unroll
        for (int n = 0; n < 2; ++n)
#pragma unroll
          for (int j = 0; j < 4; ++j) gv[bj][n][j] = gain[32 * bj + 16 * n + 4 * fq + j];
    }
#pragma unroll
    for (int ai = 0; ai < 2; ++ai)
#pragma unroll
      for (int m = 0; m < 4; ++m) {
        const int tok = 256 * u.pm + 128 * ai + 64 * wr + 16 * m + fr;
        const float rsx = rstd[tok];
        float x[2][2][4];
#pragma unroll
        for (int bj = 0; bj < 2; ++bj)
#pragma unroll
          for (int n = 0; n < 2; ++n)
#pragma unroll
            for (int j = 0; j < 4; ++j) x[bj][n][j] = acc[ai][bj][m][n][j] * rsx;
        if (gain || ssq_out) {
          float ss = 0.f;
#pragma unroll
          for (int bj = 0; bj < 2; ++bj)
#pragma unroll
            for (int n = 0; n < 2; ++n)
#pragma unroll
              for (int j = 0; j < 4; ++j) ss += x[bj][n][j] * x[bj][n][j];
          ss += __shfl_xor(ss, 16); ss += __shfl_xor(ss, 32);
          if (ssq_out && fq == 0) ssq_out[(size_t)tok * 8] = ss;
          if (gain) {
            const float rstd = frsq(ss * (1.f / 64.f) + EPS);
#pragma unroll
            for (int bj = 0; bj < 2; ++bj)
#pragma unroll
              for (int n = 0; n < 2; ++n)
#pragma unroll
                for (int j = 0; j < 4; ++j) x[bj][n][j] *= rstd * gv[bj][n][j];
          }
        }
        if (rope) {
          const int s = tok & (SEQ - 1);
#pragma unroll
          for (int bj = 0; bj < 2; ++bj) {
            const int pos = (rope == 2) ? s : (bj == 0 ? (s >> 6) : (s & 63));
            const float4* tp = (const float4*)(tab + pos * 16 + 4 * fq);
            const float4 c01 = tp[0], c23 = tp[1];
            const float cs[4] = {c01.x, c01.z, c23.x, c23.z}, sn[4] = {c01.y, c01.w, c23.y, c23.w};
#pragma unroll
            for (int j = 0; j < 4; ++j) {
              const float x1 = x[bj][0][j], x2 = x[bj][1][j];
              x[bj][0][j] = x1 * cs[j] - x2 * sn[j];
              x[bj][1][j] = x1 * sn[j] + x2 * cs[j];
            }
          }
        }
#pragma unroll
        for (int bj = 0; bj < 2; ++bj)
#pragma unroll
          for (int n = 0; n < 2; ++n) {
            uint2 w;
            w.x = pk_bf16(x[bj][n][0] * scale, x[bj][n][1] * scale);
            w.y = pk_bf16(x[bj][n][2] * scale, x[bj][n][3] * scale);
            *(uint2*)(dst + (size_t)tok * 64 + 32 * bj + 16 * n + 4 * fq) = w;
          }
        if (is_k) {
          float s0 = 0.f, s1 = 0.f;
#pragma unroll
          for (int n = 0; n < 2; ++n)
#pragma unroll
            for (int j = 0; j < 4; ++j) { s0 += x[0][n][j] * x[0][n][j]; s1 += x[1][n][j] * x[1][n][j]; }
          s0 += __shfl_xor(s0, 16); s0 += __shfl_xor(s0, 32);
          s1 += __shfl_xor(s1, 16); s1 += __shfl_xor(s1, 32);
          kmx0 = fmaxf(kmx0, s0); kmx1 = fmaxf(kmx1, s1);
        }
      }
    if (is_k) {
#pragma unroll
      for (int o = 1; o < 16; o <<= 1) { kmx0 = fmaxf(kmx0, __shfl_xor(kmx0, o)); kmx1 = fmaxf(kmx1, __shfl_xor(kmx1, o)); }
      if (fr == 0 && fq == 0) {
        unsigned* km = (unsigned*)(p->ws + OFF_KMAX) + (layer * 16 + (u.pm >> 4)) * 32;
        if (slot < 6) atomic_max_pos(km + KM_A + (slot - 4), kmx0 + kmx1);
        else if (slot < 14) { atomic_max_pos(km + KM_C + (slot - 10) * 2, kmx0); atomic_max_pos(km + KM_C + (slot - 10) * 2 + 1, kmx1); }
        else if (slot < 22) atomic_max_pos(km + KM_D + (slot - 18), kmx0 + kmx1);
        else atomic_max_pos(km + KM_BR, kmx0 + kmx1);
      }
    }
  }
};

struct EpiVt {
  static constexpr int BMAP = 1;
  bf16_t* big; const float* rstd;
  DI void operator()(const f32x4 (&acc)[2][2][4][2], const Unit& u, int wr, int wc, int fr, int fq) const {
    f32x4 rs[2][2];
#pragma unroll
    for (int bj = 0; bj < 2; ++bj) {
      const float* rp = rstd + 256 * u.pn + 64 * wc + 32 * bj + 8 * fq;
      rs[bj][0] = *(const f32x4*)rp; rs[bj][1] = *(const f32x4*)(rp + 4);
    }
#pragma unroll
    for (int ai = 0; ai < 2; ++ai) {
      const int vslot = 4 * u.pm + 2 * ai + wr;
      if (vslot < 10) {
        bf16_t* dst = big + (size_t)(SL_AV + vslot) * SLOT_ELEMS;
#pragma unroll
        for (int m = 0; m < 4; ++m) {
          const int dim = 16 * m + fr;
#pragma unroll
          for (int bj = 0; bj < 2; ++bj) {
            const int tgrp = 256 * u.pn + 64 * wc + 32 * bj + (fq >> 1) * 16;
            const int b = tgrp >> 12, s = tgrp & (SEQ - 1);
            const f32x4 a = acc[ai][bj][m][0] * rs[bj][0], c = acc[ai][bj][m][1] * rs[bj][1];
            uint2 w0, w1;
            w0.x = pk_bf16(a[0], a[1]); w0.y = pk_bf16(a[2], a[3]);
            w1.x = pk_bf16(c[0], c[1]); w1.y = pk_bf16(c[2], c[3]);
            bf16_t* gp = dst + ((size_t)(b * 64 + dim)) * SEQ + s + (fq & 1) * 4;
            *(uint2*)gp = w0;
            *(uint2*)(gp + 8) = w1;
          }
        }
      }
    }
  }
};

struct EpiB16 {
  static constexpr int BMAP = 1;
  bf16_t* C; int ldc;
  DI void operator()(const f32x4 (&acc)[2][2][4][2], const Unit& u, int wr, int wc, int fr, int fq) const {
#pragma unroll
    for (int ai = 0; ai < 2; ++ai)
#pragma unroll
      for (int m = 0; m < 4; ++m) {
        bf16_t* rowp = C + (size_t)(256 * u.pm + 128 * ai + 64 * wr + 16 * m + fr) * ldc + 256 * u.pn + 64 * wc + 8 * fq;
#pragma unroll
        for (int bj = 0; bj < 2; ++bj) {
          const f32x4 a = acc[ai][bj][m][0], b = acc[ai][bj][m][1];
          u32x4 w;
          w.x = pk_bf16(a[0], a[1]); w.y = pk_bf16(a[2], a[3]); w.z = pk_bf16(b[0], b[1]); w.w = pk_bf16(b[2], b[3]);
          *(u32x4*)(rowp + 32 * bj) = w;
        }
      }
  }
};

struct EpiRelu2 {
  static constexpr int BMAP = 1;
  bf16_t* O; int ldc; const float* rstd;
  DI void operator()(const f32x4 (&acc)[2][2][4][2], const Unit& u, int wr, int wc, int fr, int fq) const {
#pragma unroll
    for (int ai = 0; ai < 2; ++ai)
#pragma unroll
      for (int m = 0; m < 4; ++m) {
        const int tok = 256 * u.pm + 128 * ai + 64 * wr + 16 * m + fr;
        bf16_t* rowp = O + (size_t)(tok >> 8) * ((size_t)ldc * 256) + (size_t)(4 * u.pn + wc) * (256 * 64) + (size_t)(tok & 255) * 64 + 8 * fq;
        const float rsx = rstd[tok];
#pragma unroll
        for (int bj = 0; bj < 2; ++bj) {
          f32x4 a = acc[ai][bj][m][0], b = acc[ai][bj][m][1];
#pragma unroll
          for (int j = 0; j < 4; ++j) { a[j] = fmaxf(a[j], 0.f) * rsx; a[j] *= a[j]; b[j] = fmaxf(b[j], 0.f) * rsx; b[j] *= b[j]; }
          u32x4 w;
          w.x = pk_bf16(a[0], a[1]); w.y = pk_bf16(a[2], a[3]); w.z = pk_bf16(b[0], b[1]); w.w = pk_bf16(b[2], b[3]);
          *(u32x4*)(rowp + 32 * bj) = w;
        }
      }
  }
};
}

template <int G>
DI void phase_gemm8(const Params& p, int layer, char* smem) {
  PG8_LAS unsigned char* lds = (PG8_LAS unsigned char*)smem;
  bf16_t* big = (bf16_t*)(p.ws + OFF_BIG);
  const bf16_t* act = (const bf16_t*)(p.ws + OFF_ACT);
  const float* rstd = (const float*)(p.ws + OFF_RSTD);
  pg8::StaticOrder S;
  if (G == G_IN) {
    const bf16_t* W = (const bf16_t*)(p.ws + OFF_WIN) + (size_t)layer * 2560 * 1024;
    { pg8::Gemm g{act, W, T_TOK, 1792, 1024}; S.init(T_TOK, 1792, gridDim.x, blockIdx.x); pg8::EpiIn E{&p, layer, rstd}; pg8::gemm_phase(lds, g, S, E); }
    { pg8::Gemm g{W + (size_t)1792 * 1024, act, 768, T_TOK, 1024}; S.init(768, T_TOK, gridDim.x, blockIdx.x); pg8::EpiVt E{big, rstd}; pg8::gemm_phase(lds, g, S, E); }
  } else if (G == G_OUT) {
    const bf16_t* W = (const bf16_t*)(p.ws + OFF_WOUT) + (size_t)layer * 1024 * 1024;
    pg8::Gemm g{(const bf16_t*)(p.ws + OFF_OCAT), W, T_TOK, 1024, 1024, 1}; S.init(T_TOK, 1024, gridDim.x, blockIdx.x); pg8::EpiB16 E{(bf16_t*)(p.ws + OFF_MIX), 1024}; pg8::gemm_phase(lds, g, S, E);
  } else if (G == G_UP) {
    const bf16_t* W = (const bf16_t*)(p.ws + OFF_WUP) + (size_t)layer * 4096 * 1024;
    pg8::Gemm g{act, W, T_TOK, 4096, 1024}; S.init(T_TOK, 4096, gridDim.x, blockIdx.x); pg8::EpiRelu2 E{big, 4096, rstd}; pg8::gemm_phase(lds, g, S, E);
  } else {
    const bf16_t* W = (const bf16_t*)(p.ws + OFF_WDN) + (size_t)layer * 1024 * 4096;
    pg8::Gemm g{big, W, T_TOK, 1024, 4096, 1}; S.init(T_TOK, 1024, gridDim.x, blockIdx.x, 1); pg8::EpiB16 E{(bf16_t*)(p.ws + OFF_MIX), 1024}; pg8::gemm_phase(lds, g, S, E);
  }
}

constexpr int A_VOFF = 26624, A_STAGE = 26624 + 64 * 272, A_BIAS = 2 * A_STAGE, A_STASH = 98304;
constexpr int V_ROW = 272;

struct NaInfo { int r0q, c0, rq, cq; const float* sb; };

template <int NCH, int MODE, bool BOUND>
DI void flash_head(const bf16_t* q0p, const bf16_t* q1p, const bf16_t* q2p, const bf16_t* k0p, const bf16_t* k1p, const bf16_t* k2p,
                   const bf16_t* vt, int b, int qtok, int t0, int t1, float slope2, const NaInfo& na, char* smem,
                   f32x16& o0, f32x16& o1, float negM) {
  constexpr int KSTR = NCH * 64 + 16;
  const int tid = otid(), lane = tid & 63, r = lane & 31, h = lane >> 5;
  bf16x8 qf[NCH][2];
#pragma unroll
  for (int c = 0; c < NCH; ++c) {
    const bf16_t* qp = (c == 0) ? q0p : (c == 1) ? q1p : q2p;
#pragma unroll
    for (int ks = 0; ks < 2; ++ks) qf[c][ks] = *(const bf16x8*)(qp + (size_t)qtok * 64 + ks * 16 + 8 * h);
  }
  const int krow = tid >> 2, kseg = tid & 3;
  const size_t koff_g = ((size_t)b * SEQ + krow) * 64 + kseg * 8;
  const int kdst = krow * KSTR + kseg * 16;
  const int vd = tid >> 4, vseg = tid & 15;
  const bf16_t* vsrc = vt + ((size_t)b * 64 + vd) * SEQ + vseg * 8;
  const int vdst = A_VOFF + vd * V_ROW + vseg * 16;
  uint4 kr0, kr1, kr2, vr0, vr1;
  auto gload_k = [&](int t) {
    kr0 = *(const uint4*)(k0p + koff_g + (size_t)t * 128 * 64);
    if (NCH > 1) kr1 = *(const uint4*)(k1p + koff_g + (size_t)t * 128 * 64);
    if (NCH > 2) kr2 = *(const uint4*)(k2p + koff_g + (size_t)t * 128 * 64);
  };
  auto gload_v = [&](int t) {
    vr0 = *(const uint4*)(vsrc + t * 128);
    vr1 = *(const uint4*)(vsrc + (size_t)32 * SEQ + t * 128);
  };
  auto lstore = [&](char* st) {
    *(uint4*)(st + kdst) = kr0;
    if (NCH > 1) *(uint4*)(st + kdst + 64) = kr1;
    if (NCH > 2) *(uint4*)(st + kdst + 128) = kr2;
    *(uint4*)(st + vdst) = vr0;
    *(uint4*)(st + vdst + 32 * V_ROW) = vr1;
  };
  kr1 = make_uint4(0, 0, 0, 0); kr2 = kr1;
  gload_k(t0); gload_v(t0);
  lstore(smem);
  __syncthreads();

#pragma unroll
  for (int c = 0; c < NCH; ++c)
#pragma unroll
    for (int ks = 0; ks < 2; ++ks) asm volatile("" : "+v"(qf[c][ks]));
  float m = -1e30f, l = 0.f;
#pragma unroll
  for (int i = 0; i < 16; ++i) { o0[i] = 0.f; o1[i] = 0.f; }
  const int qpos = qtok & (SEQ - 1);

  auto stage_qk = [&](const char* cur, int t, int hf, f32x16& s0, f32x16& s1) {
#pragma unroll
    for (int i = 0; i < 16; ++i) { s0[i] = 0.f; s1[i] = 0.f; }
    const char* kb0 = cur + (hf * 64 + r) * KSTR + h * 16;
    constexpr int NC2 = NCH < 2 ? NCH : 2;
    bf16x8 ka[NC2][2], kb[NC2][2], kc[2], kd[2];
#pragma unroll
    for (int c = 0; c < NC2; ++c)
#pragma unroll
      for (int ks = 0; ks < 2; ++ks) {
        ka[c][ks] = *(const bf16x8*)(kb0 + c * 64 + ks * 32);
        kb[c][ks] = *(const bf16x8*)(kb0 + 32 * KSTR + c * 64 + ks * 32);
      }
    __builtin_amdgcn_sched_barrier(0);
    if (NCH == 3) {
#pragma unroll
      for (int ks = 0; ks < 2; ++ks) {
        kc[ks] = *(const bf16x8*)(kb0 + 2 * 64 + ks * 32);
        kd[ks] = *(const bf16x8*)(kb0 + 32 * KSTR + 2 * 64 + ks * 32);
      }
    }
#pragma unroll
    for (int c = 0; c < NC2; ++c)
#pragma unroll
      for (int ks = 0; ks < 2; ++ks) {
        s0 = MFMA(ka[c][ks], qf[c][ks], s0);
        s1 = MFMA(kb[c][ks], qf[c][ks], s1);
      }
    if (NCH == 3) {
#pragma unroll
      for (int ks = 0; ks < 2; ++ks) {
        s0 = MFMA(kc[ks], qf[NCH - 1][ks], s0);
        s1 = MFMA(kd[ks], qf[NCH - 1][ks], s1);
      }
    }
    if (MODE == 1) {
      const float rel = (float)(qpos - t * 128 - hf * 64 - 4 * h);
#pragma unroll
      for (int i = 0; i < 16; ++i) {
        const float ci = (float)((i & 3) + 8 * (i >> 2));
        s0[i] -= slope2 * fabsf(rel - ci);
        s1[i] -= slope2 * fabsf(rel - (ci + 32.f));
      }
    }
    if (MODE == 2) {
      const float* sbr = na.sb + (2 * t + hf - na.rq + 7) * 31;
#pragma unroll
      for (int i = 0; i < 16; ++i) {
        const int kc0 = crow(i, h), kc1 = 32 + crow(i, h);
        const int dc0 = min(max(kc0 - na.cq + 15, 0), 30), dc1 = min(max(kc1 - na.cq + 15, 0), 30);
        const float b0 = sbr[dc0], b1 = sbr[dc1];
        s0[i] = ((unsigned)(kc0 - na.c0) < 16u) ? s0[i] + b0 : -1e30f;
        s1[i] = ((unsigned)(kc1 - na.c0) < 16u) ? s1[i] + b1 : -1e30f;
      }
    }
  };
  auto stage_pv = [&](const char* cur, int hf, f32x16& s0, f32x16& s1) {
    if (BOUND) {
      float ps = 0.f;
#pragma unroll
      for (int i = 0; i < 16; ++i) {
        s0[i] = fexp2(s0[i]);
        s1[i] = fexp2(s1[i]);
        ps += s0[i] + s1[i];
      }
      l += ps;
    } else {
      float mx = fmaxf(s0[0], s1[0]);
#pragma unroll
      for (int i = 1; i < 16; ++i) mx = fmaxf(mx, fmaxf(s0[i], s1[i]));
      mx = fmaxf(mx, xhalf(mx));
      const float mnew = fmaxf(m, mx);
      const float alpha = fexp2(m - mnew);
      m = mnew;
      float ps = 0.f;
#pragma unroll
      for (int i = 0; i < 16; ++i) {
        s0[i] = fexp2(s0[i] - mnew);
        s1[i] = fexp2(s1[i] - mnew);
        ps += s0[i] + s1[i];
      }
      l = l * alpha + ps;
#pragma unroll
      for (int i = 0; i < 16; ++i) { o0[i] *= alpha; o1[i] *= alpha; }
    }
    const char* vb0 = cur + A_VOFF + r * V_ROW + hf * 128 + 16 * h;
#pragma unroll
    for (int kb = 0; kb < 2; ++kb)
#pragma unroll
      for (int s = 0; s < 2; ++s) {
        uint4 pu;
        if (kb == 0) {
          pu.x = pk_bf16(s0[8 * s + 0], s0[8 * s + 1]); pu.y = pk_bf16(s0[8 * s + 2], s0[8 * s + 3]);
          pu.z = pk_bf16(s0[8 * s + 4], s0[8 * s + 5]); pu.w = pk_bf16(s0[8 * s + 6], s0[8 * s + 7]);
        } else {
          pu.x = pk_bf16(s1[8 * s + 0], s1[8 * s + 1]); pu.y = pk_bf16(s1[8 * s + 2], s1[8 * s + 3]);
          pu.z = pk_bf16(s1[8 * s + 4], s1[8 * s + 5]); pu.w = pk_bf16(s1[8 * s + 6], s1[8 * s + 7]);
        }
        const bf16x8 pf = __builtin_bit_cast(bf16x8, pu);
        const int koff = (kb * 32 + 16 * s) * 2;
        {
          const bf16x8 vf = *(const bf16x8*)(vb0 + koff);
          o0 = MFMA(vf, pf, o0);
        }
        {
          const bf16x8 vf = *(const bf16x8*)(vb0 + 32 * V_ROW + koff);
          o1 = MFMA(vf, pf, o1);
        }
      }
  };
#pragma nounroll
  for (int t = t0; t < t1; ++t) {
    const char* cur = smem + ((t - t0) & 1) * A_STAGE;
    const bool more = (t + 1 < t1);
    if (more) gload_k(t + 1);
    f32x16 a0, a1, c0, c1;
    if (MODE == 2) {
      if (more) gload_v(t + 1);
      const bool act0 = (2 * t >= na.r0q) && (2 * t < na.r0q + 8), act1 = (2 * t + 1 >= na.r0q) && (2 * t + 1 < na.r0q + 8);
      if (act0) { stage_qk(cur, t, 0, a0, a1); stage_pv(cur, 0, a0, a1); }
      if (act1) { stage_qk(cur, t, 1, c0, c1); stage_pv(cur, 1, c0, c1); }
    } else {
      stage_qk(cur, t, 0, a0, a1);
      gload_v(more ? t + 1 : t);
      stage_pv(cur, 0, a0, a1);
      stage_qk(cur, t, 1, a0, a1);
      stage_pv(cur, 1, a0, a1);
    }
    if (more) lstore(smem + ((t - t0 + 1) & 1) * A_STAGE);
    __syncthreads();
  }
  l += xhalf(l);
  const float inv = 1.f / l;
#pragma unroll
  for (int i = 0; i < 16; ++i) { o0[i] *= inv; o1[i] *= inv; }
}

template <int NCH, int MODE>
DI void flash_auto(const bf16_t* q0p, const bf16_t* q1p, const bf16_t* q2p, const bf16_t* k0p, const bf16_t* k1p, const bf16_t* k2p,
                   const bf16_t* vt, int b, int qtok, int t0, int t1, float slope2, const NaInfo& na, char* smem,
                   f32x16& o0, f32x16& o1, float kmax_pad, float addb) {
  const int h = (otid() & 63) >> 5;
  float qss = 0.f;
#pragma unroll
  for (int c = 0; c < NCH; ++c) {
    const bf16_t* qp = (c == 0) ? q0p : (c == 1) ? q1p : q2p;
#pragma unroll
    for (int ks = 0; ks < 2; ++ks) {
      const uint4 u = *(const uint4*)(qp + (size_t)qtok * 64 + ks * 16 + 8 * h);
      qss += bf_lo(u.x) * bf_lo(u.x) + bf_hi(u.x) * bf_hi(u.x) + bf_lo(u.y) * bf_lo(u.y) + bf_hi(u.y) * bf_hi(u.y)
           + bf_lo(u.z) * bf_lo(u.z) + bf_hi(u.z) * bf_hi(u.z) + bf_lo(u.w) * bf_lo(u.w) + bf_hi(u.w) * bf_hi(u.w);
    }
  }
  qss += xhalf(qss);
  const float M = sqrtf(qss) * kmax_pad + addb;
  int* flag = (int*)(smem + A_BIAS + 8192 + 16);
  if (otid() == 0) *flag = 0;
  __syncthreads();
  if (!(M < 64.f)) *flag = 1;
  __syncthreads();
  if (*flag) flash_head<NCH, MODE, false>(q0p, q1p, q2p, k0p, k1p, k2p, vt, b, qtok, t0, t1, slope2, na, smem, o0, o1, 0.f);
  else if (MODE == 1) {
    const int q0 = (qtok & (SEQ - 1)) & ~255;
    const int D = (int)(214.f / slope2) + 1;
    const int ta = max(0, (q0 - D) >> 7), tb = min(32, ((q0 + 255 + D) >> 7) + 1);
    flash_head<NCH, MODE, true>(q0p, q1p, q2p, k0p, k1p, k2p, vt, b, qtok, ta, tb, slope2, na, smem, o0, o1, -M);
  }
  else flash_head<NCH, MODE, true>(q0p, q1p, q2p, k0p, k1p, k2p, vt, b, qtok, t0, t1, slope2, na, smem, o0, o1, -M);
}

template <int DUAL, bool BOUND>
DI void flash_dual(const bf16_t* qA0, const bf16_t* qA1, const bf16_t* qB0, const bf16_t* qB1, const bf16_t* k0p, const bf16_t* k1p,
                   const bf16_t* vt, int b, int qtok, int t0, int t1, float slope2, char* smem,
                   f32x16& oA0, f32x16& oA1, f32x16& oB0, f32x16& oB1) {
  constexpr int KSTR = 2 * 64 + 16;
  const int tid = otid(), lane = tid & 63, r = lane & 31, h = lane >> 5;
  bf16x8 qa[2][2], qb[2][2];
#pragma unroll
  for (int ks = 0; ks < 2; ++ks) {
    qa[0][ks] = *(const bf16x8*)(qA0 + (size_t)qtok * 64 + ks * 16 + 8 * h);
    qb[1][ks] = *(const bf16x8*)(qB1 + (size_t)qtok * 64 + ks * 16 + 8 * h);
    if (DUAL == 1) {
      qa[1][ks] = *(const bf16x8*)(qA1 + (size_t)qtok * 64 + ks * 16 + 8 * h);
      qb[0][ks] = *(const bf16x8*)(qB0 + (size_t)qtok * 64 + ks * 16 + 8 * h);
    } else { qa[1][ks] = qa[0][ks]; qb[0][ks] = qb[1][ks]; }
  }
  const int krow = tid >> 2, kseg = tid & 3;
  const size_t koff_g = ((size_t)b * SEQ + krow) * 64 + kseg * 8;
  const int kdst = krow * KSTR + kseg * 16;
  const int vd = tid >> 4, vseg = tid & 15;
  const bf16_t* vsrc = vt + ((size_t)b * 64 + vd) * SEQ + vseg * 8;
  const int vdst = A_VOFF + vd * V_ROW + vseg * 16;
  uint4 kr0, kr1, vr0, vr1;
  auto gload_k = [&](int t) {
    kr0 = *(const uint4*)(k0p + koff_g + (size_t)t * 128 * 64);
    kr1 = *(const uint4*)(k1p + koff_g + (size_t)t * 128 * 64);
  };
  auto gload_v = [&](int t) {
    vr0 = *(const uint4*)(vsrc + t * 128);
    vr1 = *(const uint4*)(vsrc + (size_t)32 * SEQ + t * 128);
  };
  auto lstore = [&](char* st) {
    *(uint4*)(st + kdst) = kr0;
    *(uint4*)(st + kdst + 64) = kr1;
    *(uint4*)(st + vdst) = vr0;
    *(uint4*)(st + vdst + 32 * V_ROW) = vr1;
  };
  gload_k(t0); gload_v(t0);
  lstore(smem);
  __syncthreads();
#pragma unroll
  for (int c = 0; c < 2; ++c)
#pragma unroll
    for (int ks = 0; ks < 2; ++ks) { asm volatile("" : "+v"(qa[c][ks])); asm volatile("" : "+v"(qb[c][ks])); }
  float mA = -1e30f, lA = 0.f, mB = -1e30f, lB = 0.f;
#pragma unroll
  for (int i = 0; i < 16; ++i) { oA0[i] = 0.f; oA1[i] = 0.f; oB0[i] = 0.f; oB1[i] = 0.f; }
  const int qpos = qtok & (SEQ - 1);

  auto softmax_pv = [&](const char* cur, int hf, f32x16& s0, f32x16& s1, float& m, float& l, f32x16& o0, f32x16& o1) {
    if (BOUND) {
      float ps = 0.f;
#pragma unroll
      for (int i = 0; i < 16; ++i) {
        s0[i] = fexp2(s0[i]);
        s1[i] = fexp2(s1[i]);
        ps += s0[i] + s1[i];
      }
      l += ps;
    } else {
      float mx = fmaxf(s0[0], s1[0]);
#pragma unroll
      for (int i = 1; i < 16; ++i) mx = fmaxf(mx, fmaxf(s0[i], s1[i]));
      mx = fmaxf(mx, xhalf(mx));
      const float mnew = fmaxf(m, mx);
      const float alpha = fexp2(m - mnew);
      m = mnew;
      float ps = 0.f;
#pragma unroll
      for (int i = 0; i < 16; ++i) {
        s0[i] = fexp2(s0[i] - mnew);
        s1[i] = fexp2(s1[i] - mnew);
        ps += s0[i] + s1[i];
      }
      l = l * alpha + ps;
#pragma unroll
      for (int i = 0; i < 16; ++i) { o0[i] *= alpha; o1[i] *= alpha; }
    }
    const char* vb0 = cur + A_VOFF + r * V_ROW + hf * 128 + 16 * h;
#pragma unroll
    for (int kb = 0; kb < 2; ++kb)
#pragma unroll
      for (int s = 0; s < 2; ++s) {
        uint4 pu;
        if (kb == 0) {
          pu.x = pk_bf16(s0[8 * s + 0], s0[8 * s + 1]); pu.y = pk_bf16(s0[8 * s + 2], s0[8 * s + 3]);
          pu.z = pk_bf16(s0[8 * s + 4], s0[8 * s + 5]); pu.w = pk_bf16(s0[8 * s + 6], s0[8 * s + 7]);
        } else {
          pu.x = pk_bf16(s1[8 * s + 0], s1[8 * s + 1]); pu.y = pk_bf16(s1[8 * s + 2], s1[8 * s + 3]);
          pu.z = pk_bf16(s1[8 * s + 4], s1[8 * s + 5]); pu.w = pk_bf16(s1[8 * s + 6], s1[8 * s + 7]);
        }
        const bf16x8 pf = __builtin_bit_cast(bf16x8, pu);
        const int koff = (kb * 32 + 16 * s) * 2;
        {
          const bf16x8 vf = *(const bf16x8*)(vb0 + koff);
          o0 = MFMA(vf, pf, o0);
        }
        {
          const bf16x8 vf = *(const bf16x8*)(vb0 + 32 * V_ROW + koff);
          o1 = MFMA(vf, pf, o1);
        }
      }
  };
#pragma nounroll
  for (int t = t0; t < t1; ++t) {
    const char* cur = smem + ((t - t0) & 1) * A_STAGE;
    const bool more = (t + 1 < t1);
    if (more) gload_k(t + 1);
#pragma nounroll
    for (int hf = 0; hf < 2; ++hf) {
      if (hf == 1) gload_v(more ? t + 1 : t);
      const char* kb0 = cur + (hf * 64 + r) * KSTR + h * 16;
      f32x16 s0, s1;
      const float rel = (float)(qpos - t * 128 - hf * 64 - 4 * h);
#pragma unroll
      for (int st = 0; st < 2; ++st) {
        constexpr int NCS = (DUAL == 1) ? 2 : 1;
        bf16x8 ka[NCS][2], kb[NCS][2];
        __builtin_amdgcn_sched_barrier(0);
#pragma unroll
        for (int cc = 0; cc < NCS; ++cc) {
          const int c = (DUAL == 1) ? cc : st;
#pragma unroll
          for (int ks = 0; ks < 2; ++ks) {
            ka[cc][ks] = *(const bf16x8*)(kb0 + c * 64 + ks * 32);
            kb[cc][ks] = *(const bf16x8*)(kb0 + 32 * KSTR + c * 64 + ks * 32);
          }
        }
        __builtin_amdgcn_sched_barrier(0);
#pragma unroll
        for (int i = 0; i < 16; ++i) { s0[i] = 0.f; s1[i] = 0.f; }
#pragma unroll
        for (int cc = 0; cc < NCS; ++cc) {
          const int c = (DUAL == 1) ? cc : st;
#pragma unroll
          for (int ks = 0; ks < 2; ++ks) {
            if (st == 0) { s0 = MFMA(ka[cc][ks], qa[c][ks], s0); s1 = MFMA(kb[cc][ks], qa[c][ks], s1); }
            else         { s0 = MFMA(ka[cc][ks], qb[c][ks], s0); s1 = MFMA(kb[cc][ks], qb[c][ks], s1); }
          }
        }
        if (DUAL == 2) {
#pragma unroll
          for (int i = 0; i < 16; ++i) {
            const float ci = (float)((i & 3) + 8 * (i >> 2));
            s0[i] -= slope2 * fabsf(rel - ci);
            s1[i] -= slope2 * fabsf(rel - (ci + 32.f));
          }
        }
        if (st == 0) softmax_pv(cur, hf, s0, s1, mA, lA, oA0, oA1);
        else         softmax_pv(cur, hf, s0, s1, mB, lB, oB0, oB1);
      }
    }
    if (more) lstore(smem + ((t - t0 + 1) & 1) * A_STAGE);
    __syncthreads();
  }
  lA += xhalf(lA); lB += xhalf(lB);
  const float ia = 1.f / lA, ib = 1.f / lB;
#pragma unroll
  for (int i = 0; i < 16; ++i) { oA0[i] *= ia; oA1[i] *= ia; oB0[i] *= ib; oB1[i] *= ib; }
}

template <int DUAL>
DI void flash_dual_auto(const bf16_t* qA0, const bf16_t* qA1, const bf16_t* qB0, const bf16_t* qB1, const bf16_t* k0p, const bf16_t* k1p,
                        const bf16_t* vt, int b, int qtok, float slope2, char* smem,
                        f32x16& oA0, f32x16& oA1, f32x16& oB0, f32x16& oB1, float kmaxA, float kmaxB) {
  const int h = (otid() & 63) >> 5;
  auto sumsq = [&](const bf16_t* qp) {
    float ss = 0.f;
#pragma unroll
    for (int ks = 0; ks < 2; ++ks) {
      const uint4 u = *(const uint4*)(qp + (size_t)qtok * 64 + ks * 16 + 8 * h);
      ss += bf_lo(u.x) * bf_lo(u.x) + bf_hi(u.x) * bf_hi(u.x) + bf_lo(u.y) * bf_lo(u.y) + bf_hi(u.y) * bf_hi(u.y)
          + bf_lo(u.z) * bf_lo(u.z) + bf_hi(u.z) * bf_hi(u.z) + bf_lo(u.w) * bf_lo(u.w) + bf_hi(u.w) * bf_hi(u.w);
    }
    return ss;
  };
  float qsA = sumsq(qA0), qsB = sumsq(qB1);
  if (DUAL == 1) { qsA += sumsq(qA1); qsB += sumsq(qB0); }
  qsA += xhalf(qsA); qsB += xhalf(qsB);
  const float M = fmaxf(sqrtf(qsA) * kmaxA, sqrtf(qsB) * kmaxB);
  int* flag = (int*)(smem + A_BIAS + 8192 + 16);
  if (otid() == 0) *flag = 0;
  __syncthreads();
  if (!(M < 64.f)) *flag = 1;
  __syncthreads();
  if (*flag) {
    NaInfo nz; nz.r0q = 0; nz.c0 = 0; nz.rq = 0; nz.cq = 0; nz.sb = nullptr;
    if (DUAL == 1) {
      flash_head<2, 0, false>(qA0, qA1, qA0, k0p, k1p, k0p, vt, b, qtok, 0, 32, 0.f, nz, smem, oA0, oA1, 0.f);
      flash_head<2, 0, false>(qB0, qB1, qB0, k0p, k1p, k0p, vt, b, qtok, 0, 32, 0.f, nz, smem, oB0, oB1, 0.f);
    } else {
      flash_head<1, 1, false>(qA0, qA0, qA0, k0p, k0p, k0p, vt, b, qtok, 0, 32, slope2, nz, smem, oA0, oA1, 0.f);
      flash_head<1, 1, false>(qB1, qB1, qB1, k1p, k1p, k1p, vt, b, qtok, 0, 32, slope2, nz, smem, oB0, oB1, 0.f);
    }
  }
  else if (DUAL == 2) {
    const int q0 = (qtok & (SEQ - 1)) & ~255;
    const int D = (int)(214.f / slope2) + 1;
    const int ta = max(0, (q0 - D) >> 7), tb = min(32, ((q0 + 255 + D) >> 7) + 1);
    flash_dual<DUAL, true>(qA0, qA1, qB0, qB1, k0p, k1p, vt, b, qtok, ta, tb, slope2, smem, oA0, oA1, oB0, oB1);
  } else flash_dual<DUAL, true>(qA0, qA1, qB0, qB1, k0p, k1p, vt, b, qtok, 0, 32, slope2, smem, oA0, oA1, oB0, oB1);
}


template <bool BOUND>
DI void flash_mla2(const bf16_t* q0p, const bf16_t* q1p, const bf16_t* q2p, const bf16_t* k0p, const bf16_t* k1p, const bf16_t* k2p,
                   const bf16_t* vt, int b, int qtokA, int qtokB, char* smem,
                   f32x16& oA0, f32x16& oA1, f32x16& oB0, f32x16& oB1) {
  constexpr int KSTR = 3 * 64 + 16;
  const int tid = otid(), lane = tid & 63, r = lane & 31, h = lane >> 5;
  bf16x8 qa[3][2], qb[3][2];
#pragma unroll
  for (int c = 0; c < 3; ++c) {
    const bf16_t* qp = (c == 0) ? q0p : (c == 1) ? q1p : q2p;
#pragma unroll
    for (int ks = 0; ks < 2; ++ks) {
      qa[c][ks] = *(const bf16x8*)(qp + (size_t)qtokA * 64 + ks * 16 + 8 * h);
      qb[c][ks] = *(const bf16x8*)(qp + (size_t)qtokB * 64 + ks * 16 + 8 * h);
    }
  }
  const int krow = tid >> 2, kseg = tid & 3;
  const size_t koff_g = ((size_t)b * SEQ + krow) * 64 + kseg * 8;
  const int kdst = krow * KSTR + kseg * 16;
  const int vd = tid >> 4, vseg = tid & 15;
  const bf16_t* vsrc = vt + ((size_t)b * 64 + vd) * SEQ + vseg * 8;
  const int vdst = A_VOFF + vd * V_ROW + vseg * 16;
  uint4 kr0, kr1, kr2, vr0, vr1;
  auto gload_k = [&](int t) {
    kr0 = *(const uint4*)(k0p + koff_g + (size_t)t * 128 * 64);
    kr1 = *(const uint4*)(k1p + koff_g + (size_t)t * 128 * 64);
    kr2 = *(const uint4*)(k2p + koff_g + (size_t)t * 128 * 64);
  };
  auto gload_v = [&](int t) {
    vr0 = *(const uint4*)(vsrc + t * 128);
    vr1 = *(const uint4*)(vsrc + (size_t)32 * SEQ + t * 128);
  };
  auto lstore = [&](char* st) {
    *(uint4*)(st + kdst) = kr0;
    *(uint4*)(st + kdst + 64) = kr1;
    *(uint4*)(st + kdst + 128) = kr2;
    *(uint4*)(st + vdst) = vr0;
    *(uint4*)(st + vdst + 32 * V_ROW) = vr1;
  };
  gload_k(0); gload_v(0);
  lstore(smem);
  __syncthreads();
#pragma unroll
  for (int c = 0; c < 3; ++c)
#pragma unroll
    for (int ks = 0; ks < 2; ++ks) { asm volatile("" : "+v"(qa[c][ks])); asm volatile("" : "+v"(qb[c][ks])); }
  float mA = -1e30f, lA = 0.f, mB = -1e30f, lB = 0.f;
#pragma unroll
  for (int i = 0; i < 16; ++i) { oA0[i] = 0.f; oA1[i] = 0.f; oB0[i] = 0.f; oB1[i] = 0.f; }

  auto softmax_pv = [&](const char* cur, int hf, f32x16& s0, f32x16& s1, float& m, float& l, f32x16& o0, f32x16& o1) {
    if (BOUND) {
      float ps = 0.f;
#pragma unroll
      for (int i = 0; i < 16; ++i) {
        s0[i] = fexp2(s0[i]);
        s1[i] = fexp2(s1[i]);
        ps += s0[i] + s1[i];
      }
      l += ps;
    } else {
      float mx = fmaxf(s0[0], s1[0]);
#pragma unroll
      for (int i = 1; i < 16; ++i) mx = fmaxf(mx, fmaxf(s0[i], s1[i]));
      mx = fmaxf(mx, xhalf(mx));
      const float mnew = fmaxf(m, mx);
      const float alpha = fexp2(m - mnew);
      m = mnew;
      float ps = 0.f;
#pragma unroll
      for (int i = 0; i < 16; ++i) {
        s0[i] = fexp2(s0[i] - mnew);
        s1[i] = fexp2(s1[i] - mnew);
        ps += s0[i] + s1[i];
      }
      l = l * alpha + ps;
#pragma unroll
      for (int i = 0; i < 16; ++i) { o0[i] *= alpha; o1[i] *= alpha; }
    }
    const char* vb0 = cur + A_VOFF + r * V_ROW + hf * 128 + 16 * h;
#pragma unroll
    for (int kb = 0; kb < 2; ++kb)
#pragma unroll
      for (int s = 0; s < 2; ++s) {
        uint4 pu;
        if (kb == 0) {
          pu.x = pk_bf16(s0[8 * s + 0], s0[8 * s + 1]); pu.y = pk_bf16(s0[8 * s + 2], s0[8 * s + 3]);
          pu.z = pk_bf16(s0[8 * s + 4], s0[8 * s + 5]); pu.w = pk_bf16(s0[8 * s + 6], s0[8 * s + 7]);
        } else {
          pu.x = pk_bf16(s1[8 * s + 0], s1[8 * s + 1]); pu.y = pk_bf16(s1[8 * s + 2], s1[8 * s + 3]);
          pu.z = pk_bf16(s1[8 * s + 4], s1[8 * s + 5]); pu.w = pk_bf16(s1[8 * s + 6], s1[8 * s + 7]);
        }
        const bf16x8 pf = __builtin_bit_cast(bf16x8, pu);
        const int koff = (kb * 32 + 16 * s) * 2;
        { const bf16x8 vf = *(const bf16x8*)(vb0 + koff); o0 = MFMA(vf, pf, o0); }
        { const bf16x8 vf = *(const bf16x8*)(vb0 + 32 * V_ROW + koff); o1 = MFMA(vf, pf, o1); }
      }
  };
#pragma nounroll
  for (int t = 0; t < 32; ++t) {
    const char* cur = smem + (t & 1) * A_STAGE;
    const bool more = (t + 1 < 32);
    if (more) gload_k(t + 1);
#pragma nounroll
    for (int hf = 0; hf < 2; ++hf) {
      if (hf == 1) gload_v(more ? t + 1 : t);
      const char* kb0 = cur + (hf * 64 + r) * KSTR + h * 16;
      f32x16 s0, s1;
#pragma unroll
      for (int st = 0; st < 2; ++st) {
        __builtin_amdgcn_sched_barrier(0);
#pragma unroll
        for (int i = 0; i < 16; ++i) { s0[i] = 0.f; s1[i] = 0.f; }
#pragma unroll
        for (int c = 0; c < 3; ++c) {
          bf16x8 ka[2], kb[2];
#pragma unroll
          for (int ks = 0; ks < 2; ++ks) {
            ka[ks] = *(const bf16x8*)(kb0 + c * 64 + ks * 32);
            kb[ks] = *(const bf16x8*)(kb0 + 32 * KSTR + c * 64 + ks * 32);
          }
#pragma unroll
          for (int ks = 0; ks < 2; ++ks) {
            if (st == 0) { s0 = MFMA(ka[ks], qa[c][ks], s0); s1 = MFMA(kb[ks], qa[c][ks], s1); }
            else         { s0 = MFMA(ka[ks], qb[c][ks], s0); s1 = MFMA(kb[ks], qb[c][ks], s1); }
          }
        }
        if (st == 0) softmax_pv(cur, hf, s0, s1, mA, lA, oA0, oA1);
        else         softmax_pv(cur, hf, s0, s1, mB, lB, oB0, oB1);
      }
    }
    if (more) lstore(smem + ((t + 1) & 1) * A_STAGE);
    __syncthreads();
  }
  lA += xhalf(lA); lB += xhalf(lB);
  const float ia = 1.f / lA, ib = 1.f / lB;
#pragma unroll
  for (int i = 0; i < 16; ++i) { oA0[i] *= ia; oA1[i] *= ia; oB0[i] *= ib; oB1[i] *= ib; }
}

DI void flash_mla2_auto(const bf16_t* q0p, const bf16_t* q1p, const bf16_t* q2p, const bf16_t* k0p, const bf16_t* k1p, const bf16_t* k2p,
                        const bf16_t* vt, int b, int qtokA, int qtokB, char* smem,
                        f32x16& oA0, f32x16& oA1, f32x16& oB0, f32x16& oB1, float kmax_pad) {
  const int h = (otid() & 63) >> 5;
  float qsA = 0.f, qsB = 0.f;
#pragma unroll
  for (int c = 0; c < 3; ++c) {
    const bf16_t* qp = (c == 0) ? q0p : (c == 1) ? q1p : q2p;
#pragma unroll
    for (int ks = 0; ks < 2; ++ks) {
      const uint4 u = *(const uint4*)(qp + (size_t)qtokA * 64 + ks * 16 + 8 * h);
      qsA += bf_lo(u.x) * bf_lo(u.x) + bf_hi(u.x) * bf_hi(u.x) + bf_lo(u.y) * bf_lo(u.y) + bf_hi(u.y) * bf_hi(u.y)
           + bf_lo(u.z) * bf_lo(u.z) + bf_hi(u.z) * bf_hi(u.z) + bf_lo(u.w) * bf_lo(u.w) + bf_hi(u.w) * bf_hi(u.w);
      const uint4 w = *(const uint4*)(qp + (size_t)qtokB * 64 + ks * 16 + 8 * h);
      qsB += bf_lo(w.x) * bf_lo(w.x) + bf_hi(w.x) * bf_hi(w.x) + bf_lo(w.y) * bf_lo(w.y) + bf_hi(w.y) * bf_hi(w.y)
           + bf_lo(w.z) * bf_lo(w.z) + bf_hi(w.z) * bf_hi(w.z) + bf_lo(w.w) * bf_lo(w.w) + bf_hi(w.w) * bf_hi(w.w);
    }
  }
  qsA += xhalf(qsA); qsB += xhalf(qsB);
  const float M = sqrtf(fmaxf(qsA, qsB)) * kmax_pad;
  int* flag = (int*)(smem + A_BIAS + 8192 + 16);
  if (otid() == 0) *flag = 0;
  __syncthreads();
  if (!(M < 64.f)) *flag = 1;
  __syncthreads();
  if (*flag) {
    NaInfo nz; nz.r0q = 0; nz.c0 = 0; nz.rq = 0; nz.cq = 0; nz.sb = nullptr;
    flash_head<3, 0, false>(q0p, q1p, q2p, k0p, k1p, k2p, vt, b, qtokA, 0, 32, 0.f, nz, smem, oA0, oA1, 0.f);
    flash_head<3, 0, false>(q0p, q1p, q2p, k0p, k1p, k2p, vt, b, qtokB, 0, 32, 0.f, nz, smem, oB0, oB1, 0.f);
  } else flash_mla2<true>(q0p, q1p, q2p, k0p, k1p, k2p, vt, b, qtokA, qtokB, smem, oA0, oA1, oB0, oB1);
}

DI float kmax_load(const Params& p, int layer, int b, int idx) {
  return __uint_as_float(((const unsigned*)(p.ws + OFF_KMAX))[(layer * 16 + b) * 32 + idx]);
}

constexpr int N_ITEMS_XCD = 208;

DI size_t ocat_off(int tok, int col) { return (size_t)(tok >> 8) * (1024 * 256) + (size_t)(col >> 6) * (256 * 64) + (size_t)(tok & 255) * 64 + (col & 63); }
DI void store_o(bf16_t* dst  , const f32x16& o0, const f32x16& o1, int h) {
#pragma unroll
  for (int g = 0; g < 4; ++g) {
    uint2 u;
    u.x = pk_bf16(o0[4 * g], o0[4 * g + 1]); u.y = pk_bf16(o0[4 * g + 2], o0[4 * g + 3]);
    *(uint2*)(dst + 8 * g + 4 * h) = u;
    u.x = pk_bf16(o1[4 * g], o1[4 * g + 1]); u.y = pk_bf16(o1[4 * g + 2], o1[4 * g + 3]);
    *(uint2*)(dst + 32 + 8 * g + 4 * h) = u;
  }
}

DI void phase_attn(const Params& p, int layer, char* smem) {
  unsigned* ctr = (unsigned*)(p.ws + OFF_CTRL) + layer * 8;
  int qsel = 0;
  int* s_item = (int*)(smem + A_BIAS + 8192);
  float* sbias = (float*)(smem + A_BIAS);
  const bf16_t* big = (const bf16_t*)(p.ws + OFF_BIG);
  bf16_t* ocat = (bf16_t*)(p.ws + OFF_OCAT);
  NaInfo na0; na0.r0q = 0; na0.c0 = 0; na0.rq = 0; na0.cq = 0; na0.sb = sbias;
  for (;;) {
    const int tid = otid(), lane = tid & 63, wave = tid >> 6, r = lane & 31, h = lane >> 5;
    __syncthreads();
    const int xq = (blockIdx.x + qsel) & 7;
    if (tid == 0) *s_item = (int)atomicAdd(ctr + xq, 1u);
    __syncthreads();
    const int it = *s_item;
    if (it >= N_ITEMS_XCD) { if (++qsel >= 8) break; continue; }
    if (it < 16) {
      const int b = xq + 8 * ((it >> 3) & 1), q5 = it & 7;
      const int qtokA = b * SEQ + q5 * 512 + wave * 64 + r, qtokB = qtokA + 32;
      float ssqA = 0.f, ssqB = 0.f;
      for (int hd = 0; hd < 4; ++hd) {
        f32x16 o0, o1, u0, u1;
        const bf16_t* qn = big + (SL_BQN + hd) * SLOT_ELEMS;
        const bf16_t* qr = big + (SL_BQR + (hd >> 1)) * SLOT_ELEMS + (hd & 1) * 32;
        const bf16_t* kn = big + (SL_BKN + hd) * SLOT_ELEMS;
        const bf16_t* krp = big + SL_KR * SLOT_ELEMS;
        const float km = sqrtf(kmax_load(p, layer, b, KM_BN + hd) + kmax_load(p, layer, b, KM_BR)) * 1.01f;
        flash_mla2_auto(qn, qn + 32, qr, kn, kn + 32, krp, big + (SL_BV + hd) * SLOT_ELEMS, b, qtokA, qtokB, smem, o0, o1, u0, u1, km);
#pragma unroll
        for (int i = 0; i < 16; ++i) { ssqA += o0[i] * o0[i] + o1[i] * o1[i]; ssqB += u0[i] * u0[i] + u1[i] * u1[i]; }
        const int tid2 = otid(), tA = b * SEQ + q5 * 512 + (tid2 >> 6) * 64 + (tid2 & 31), h2 = (tid2 >> 5) & 1;
        store_o(ocat + ocat_off(tA, 256 + hd * 64), o0, o1, h2);
        store_o(ocat + ocat_off(tA + 32, 256 + hd * 64), u0, u1, h2);
      }
      ssqA += xhalf(ssqA); ssqB += xhalf(ssqB);
      const float rstdA = frsq(ssqA * (1.f / 256.f) + EPS), rstdB = frsq(ssqB * (1.f / 256.f) + EPS);
      const int tid3 = otid(), tA3 = b * SEQ + q5 * 512 + (tid3 >> 6) * 64 + (tid3 & 31), h3 = (tid3 >> 5) & 1;
#pragma unroll 4
      for (int j = 0; j < 64; ++j) {
        const int tk = (j < 32) ? tA3 : tA3 + 32;
        const float rs = (j < 32) ? rstdA : rstdB;
        uint2* a = (uint2*)(ocat + ocat_off(tk, 256 + 8 * (j & 31) + 4 * h3));
        uint2 u = *a;
        u.x = pk_bf16(bf_lo(u.x) * rs, bf_hi(u.x) * rs);
        u.y = pk_bf16(bf_lo(u.y) * rs, bf_hi(u.y) * rs);
        *a = u;
      }
    } else if (it < 48) {
      const int x = it - 16;
      const int b = xq + 8 * ((x >> 4) & 1), qb = x & 15;
      const int qtok = b * SEQ + qb * 256 + wave * 32 + r;
      float ssq = 0.f;
      for (int pr = 0; pr < 2; ++pr) {
        f32x16 o0, o1, u0, u1;
        const bf16_t* qa = big + (SL_AQ + 2 * pr) * SLOT_ELEMS;
        const bf16_t* qb2 = big + (SL_AQ + 2 * pr + 1) * SLOT_ELEMS;
        const bf16_t* k = big + (SL_AK + pr) * SLOT_ELEMS;
        const float km = sqrtf(kmax_load(p, layer, b, KM_A + pr)) * 1.01f;
        flash_dual_auto<1>(qa, qa + 32, qb2, qb2 + 32, k, k + 32, big + (SL_AV + pr) * SLOT_ELEMS, b, qtok, 0.f, smem, o0, o1, u0, u1, km, km);
#pragma unroll
        for (int i = 0; i < 16; ++i) ssq += o0[i] * o0[i] + o1[i] * o1[i] + u0[i] * u0[i] + u1[i] * u1[i];
        const int tid2 = otid(), qtok2 = b * SEQ + qb * 256 + (tid2 >> 6) * 32 + (tid2 & 31), h2 = (tid2 >> 5) & 1;
        store_o(ocat + ocat_off(qtok2, (2 * pr) * 64), o0, o1, h2);
        store_o(ocat + ocat_off(qtok2, (2 * pr + 1) * 64), u0, u1, h2);
      }
      ssq += xhalf(ssq);
      const float rstd = frsq(ssq * (1.f / 256.f) + EPS);
#pragma unroll
      for (int j = 0; j < 32; ++j) {
        uint2* a = (uint2*)(ocat + ocat_off(qtok, 8 * j + 4 * h));
        uint2 u = *a;
        u.x = pk_bf16(bf_lo(u.x) * rstd, bf_hi(u.x) * rstd);
        u.y = pk_bf16(bf_lo(u.y) * rstd, bf_hi(u.y) * rstd);
        *a = u;
      }
    } else if (it < 144 || it >= 176) {
      int hd, bsel, qb;
      if (it < 112) { const int x = it - 48; hd = 3 - (x >> 5); bsel = (x >> 4) & 1; qb = x & 15; }
      else if (it < 144) { const int x = it - 112; hd = 1; bsel = x >> 4; qb = x & 15; }
      else { const int x = it - 176; hd = 0; bsel = x >> 4; qb = x & 15; }
      const int b = xq + 8 * bsel;
      const int qtok = b * SEQ + qb * 256 + wave * 32 + r;
      const float li = ((const float*)(p.ws + OFF_CTRL))[16 + layer * 2 + 1];
      const float lam = ((const float*)(p.ws + OFF_CTRL))[16 + layer * 2];
      const float slope2 = exp2f(-2.f * (float)(hd + 1)) * LOG2E;
      const bf16_t* q = big + (SL_CQ + hd) * SLOT_ELEMS;
      const bf16_t* k = big + (SL_CK + hd) * SLOT_ELEMS;
      const bf16_t* v = big + (SL_CV + hd) * SLOT_ELEMS;
      f32x16 a0, a1, c0, c1;
      const float km0 = sqrtf(kmax_load(p, layer, b, KM_C + hd * 2)) * 1.01f, km1 = sqrtf(kmax_load(p, layer, b, KM_C + hd * 2 + 1)) * 1.01f;
      flash_dual_auto<2>(q, q, q + 32, q + 32, k, k + 32, v, b, qtok, slope2, smem, a0, a1, c0, c1, km0, km1);
      float ssq = 0.f;
#pragma unroll
      for (int i = 0; i < 16; ++i) {
        a0[i] -= lam * c0[i]; a1[i] -= lam * c1[i];
        ssq += a0[i] * a0[i] + a1[i] * a1[i];
      }
      ssq += xhalf(ssq);
      const float rstd = frsq(ssq * (1.f / 64.f) + EPS) * (1.f - li);
      const float* gc = p.in[I_GC] + layer * 64;
#pragma unroll
      for (int i = 0; i < 16; ++i) {
        a0[i] *= rstd * gc[crow(i, h)];
        a1[i] *= rstd * gc[32 + crow(i, h)];
      }
      store_o(ocat + ocat_off(qtok, 512 + hd * 64), a0, a1, h);
    } else {
      const int x = it - 144, b = xq + 8 * (x >> 4), R4 = x & 15;
      const int qtok = b * SEQ + R4 * 256 + wave * 32 + r;
      for (int e = tid; e < 4 * 465; e += NT) sbias[e] = p.in[I_RELB][layer * 4 * 465 + e] * LOG2E;
      NaInfo na;
      na.rq = R4 * 4 + (wave >> 1);
      na.cq = (wave & 1) * 32 + r;
      na.r0q = min(max(na.rq - 4, 0), 56);
      na.c0 = min(max(na.cq - 8, 0), 48);
      const int t0 = min(max(R4 * 4 - 4, 0), 56) >> 1, t1 = ((min(max(R4 * 4 + 3 - 4, 0), 56) + 7) >> 1) + 1;
      float ssq = 0.f;
      for (int hd = 0; hd < 4; ++hd) {
        f32x16 o0, o1;
        na.sb = sbias + hd * 465;
        const bf16_t* q = big + (SL_DQ + hd) * SLOT_ELEMS;
        const bf16_t* k = big + (SL_DK + hd) * SLOT_ELEMS;
        const float km = sqrtf(kmax_load(p, layer, b, KM_D + hd)) * 1.01f;
        const float addb = ((const float*)(p.ws + OFF_CTRL))[32 + layer * 4 + hd];
        flash_auto<2, 2>(q, q + 32, q, k, k + 32, k, big + (SL_DV + hd) * SLOT_ELEMS, b, qtok, t0, t1, 0.f, na, smem, o0, o1, km, addb);
#pragma unroll
        for (int i = 0; i < 16; ++i) ssq += o0[i] * o0[i] + o1[i] * o1[i];
        store_o(ocat + ocat_off(qtok, 768 + hd * 64), o0, o1, h);
      }
      ssq += xhalf(ssq);
      const float rstd = frsq(ssq * (1.f / 256.f) + EPS);
#pragma unroll
      for (int j = 0; j < 32; ++j) {
        uint2* a = (uint2*)(ocat + ocat_off(qtok, 768 + 8 * j + 4 * h));
        uint2 u = *a;
        u.x = pk_bf16(bf_lo(u.x) * rstd, bf_hi(u.x) * rstd);
        u.y = pk_bf16(bf_lo(u.y) * rstd, bf_hi(u.y) * rstd);
        *a = u;
      }
    }
  }
}


#define XB_TMO      128
#define XB_XCNT(j)  (256  + 64 * (j))
#define XB_XSUB(j)  (1280 + 64 * (j))
#define XB_XGEN(j)  (2304 + 64 * (j))
#define XB_TOP      3328
#define XB_TOPGEN   3392
#define XCD_BAR_WORDS 3456
#define XB_SPIN_CAP (1u << 20)
DI unsigned xb_ld(unsigned* p)              { return __hip_atomic_load(p, __ATOMIC_RELAXED, __HIP_MEMORY_SCOPE_AGENT); }
DI unsigned xb_add(unsigned* p, unsigned v) { return __hip_atomic_fetch_add(p, v, __ATOMIC_RELAXED, __HIP_MEMORY_SCOPE_AGENT); }
DI unsigned xb_xcc_id() { return (unsigned)__builtin_amdgcn_s_getreg((3 << 11) | 20) & 0xFu; }
#define XB_SPIN(cond, bar) do { unsigned _sp = 0; while (cond) { __builtin_amdgcn_s_sleep(1); \
    if ((++_sp & 255u) == 0u) { if (xb_ld(&(bar)[XB_TMO])) break; if (_sp > XB_SPIN_CAP) { atomicAdd(&(bar)[XB_TMO], 1u); break; } } } } while (0)
struct XcdBarrier { unsigned* bar; unsigned x; volatile PG8_LAS unsigned* st; };
DI XcdBarrier xcd_barrier_post(unsigned* bar, volatile PG8_LAS unsigned* st) {
  XcdBarrier b; b.bar = bar; b.x = xb_xcc_id(); b.st = st;
  if (threadIdx.x == 0) (void)xb_add(&bar[XB_XCNT(b.x)], 1u);
  return b;
}
DI void xcd_barrier_complete(unsigned* bar, unsigned x, unsigned& nloc, unsigned& nx) {
  const unsigned G = gridDim.x * gridDim.y * gridDim.z;
  unsigned sum, cnt, mine, sp = 0u;
  for (;;) {
    sum = 0u; cnt = 0u; mine = 0u;
#pragma unroll
    for (unsigned j = 0; j < 16; ++j) { const unsigned c = xb_ld(&bar[XB_XCNT(j)]); sum += c; cnt += (c > 0u) ? 1u : 0u; mine = (j == x) ? c : mine; }
    if (sum == G) break;
    __builtin_amdgcn_s_sleep(1);
    if ((++sp & 255u) == 0u) { if (xb_ld(&bar[XB_TMO])) break; if (sp > XB_SPIN_CAP) { atomicAdd(&bar[XB_TMO], 1u); break; } }
  }
  nloc = mine > 0u ? mine : 1u; nx = cnt > 0u ? cnt : 1u;
}
DI void xcd_barrier(const XcdBarrier& b) {
  asm volatile("s_waitcnt vmcnt(0)" ::: "memory");
  __syncthreads();
  if (threadIdx.x == 0) {
    unsigned* bar = b.bar;
    __builtin_amdgcn_s_waitcnt(0);
    unsigned nloc = b.st[0], nx = b.st[1];
    if (nloc == 0u) { xcd_barrier_complete(bar, b.x, nloc, nx); b.st[0] = nloc; b.st[1] = nx; }
    const unsigned old = xb_add(&bar[XB_XSUB(b.x)], 1u);
    const unsigned gen = old / nloc;
    if (old + 1u == (gen + 1u) * nloc) {
      __builtin_amdgcn_fence(__ATOMIC_RELEASE, "agent");
      asm volatile("s_waitcnt vmcnt(0)" ::: "memory");
      const unsigned og = xb_add(&bar[XB_TOP], 1u);
      const unsigned tg = og / nx;
      if (og + 1u == (tg + 1u) * nx) xb_add(&bar[XB_TOPGEN], 1u);
      else XB_SPIN(xb_ld(&bar[XB_TOPGEN]) == tg, bar);
      __builtin_amdgcn_fence(__ATOMIC_ACQUIRE, "agent");
      xb_add(&bar[XB_XGEN(b.x)], 1u);
      asm volatile("s_waitcnt vmcnt(0)" ::: "memory");
    } else {
      XB_SPIN(xb_ld(&bar[XB_XGEN(b.x)]) == gen, bar);
      __builtin_amdgcn_fence(__ATOMIC_ACQUIRE, "agent");
      asm volatile("s_waitcnt vmcnt(0)" ::: "memory");
    }
  }
  __syncthreads();
}

constexpr int N_PHASES = 17;
constexpr int LDS_MAIN = 131072;
constexpr int LDS_BYTES = LDS_MAIN + 16;

DI void run_phase(const Params& p, int ph, char* smem) {
  const bf16_t* mix = (const bf16_t*)(p.ws + OFF_MIX);
  bf16_t* act = (bf16_t*)(p.ws + OFF_ACT);
  float* rstd = (float*)(p.ws + OFF_RSTD);
  if (ph == 0) {
    phase_prep(p, smem);
    phase_resid(p.in[I_X], act, nullptr, nullptr, nullptr, rstd, true);
    return;
  }
  const int l = (ph - 1) >> 3, q = (ph - 1) & 7;
  switch (q) {
    case 0: phase_gemm8<G_IN>(p, l, smem); break;
    case 1: {
      for (int t = blockIdx.x; t < 256 * 7; t += gridDim.x) {
        if (t < 256 * 3) gemm_tile<G_UQ>(p, l, t, smem); else gemm_tile<G_UKV>(p, l, t - 256 * 3, smem);
      }
    } break;
    case 2: phase_attn(p, l, smem); break;
    case 3: phase_gemm8<G_OUT>(p, l, smem); break;
    case 4: phase_resid(nullptr, act, mix, p.in[I_NMIXPOST] + l * 1024, nullptr, rstd, true); break;
    case 5: phase_gemm8<G_UP>(p, l, smem); break;
    case 6: phase_gemm8<G_DOWN>(p, l, smem); break;
    case 7: if (l == 0) phase_resid(nullptr, act, mix, p.in[I_NMLPPOST] + l * 1024, nullptr, rstd, true);
            else phase_resid(nullptr, act, mix, p.in[I_NMLPPOST] + l * 1024, p.out, nullptr, false);
            break;
  }
}

__global__ void __launch_bounds__(NT) mega_kernel(Params p, int ph0, int ph1) {
  extern __shared__ __attribute__((aligned(16))) char smem[];
  cg::grid_group grid = cg::this_grid();
  volatile PG8_LAS unsigned* st = (volatile PG8_LAS unsigned*)(PG8_LAS unsigned char*)(smem + LDS_MAIN);
  if (threadIdx.x == 0) { st[0] = 0u; st[1] = 0u; }
  __syncthreads();
  XcdBarrier xb = xcd_barrier_post((unsigned*)(p.ws + OFF_BAR), st);
  for (int ph = ph0; ph < ph1; ++ph) {
    run_phase(p, ph, smem);
    if (ph + 1 < ph1) {
      if (ph0 < 0) grid.sync();
      xcd_barrier(xb);
    }
  }
}

extern "C" void kernel_launch(void* const* d_in, const int* in_sizes, int n_in, void* d_out, int out_size, void* d_ws, size_t ws_size,
                              hipStream_t stream) {
  static int grid_blocks = 0;
  if (!grid_blocks) {
    int dev = 0, cus = 0, per_cu = 0;
    hipGetDevice(&dev);
    hipDeviceGetAttribute(&cus, hipDeviceAttributeMultiprocessorCount, dev);
    hipFuncSetAttribute((const void*)mega_kernel, hipFuncAttributeMaxDynamicSharedMemorySize, LDS_BYTES);
    hipOccupancyMaxActiveBlocksPerMultiprocessor(&per_cu, mega_kernel, NT, LDS_BYTES);
    if (per_cu < 1) per_cu = 1;
    grid_blocks = cus * per_cu;
    if (ws_size < WS_NEED) fprintf(stderr, "workspace too small: %zu < %zu\n", ws_size, (size_t)WS_NEED);
  }
  Params p{};
  for (int i = 0; i < 24; ++i) p.in[i] = (const float*)d_in[i];
  p.out = (float*)d_out;
  p.ws = (unsigned char*)d_ws;
  hipMemsetAsync((unsigned char*)d_ws + OFF_BAR, 0, XCD_BAR_WORDS * sizeof(unsigned), stream);
#if MK_ONE_LAUNCH
  int ph0 = 0, ph1 = N_PHASES;
  void* args[] = {&p, &ph0, &ph1};
  hipError_t e = hipLaunchCooperativeKernel((const void*)mega_kernel, dim3(grid_blocks), dim3(NT), args, LDS_BYTES, stream);
  if (e != hipSuccess) fprintf(stderr, "cooperative launch failed: %s (grid %d)\n", hipGetErrorString(e), grid_blocks);
#else
  for (int ph = 0; ph < N_PHASES; ++ph)
    hipLaunchKernelGGL(mega_kernel, dim3(grid_blocks), dim3(NT), LDS_BYTES, stream, p, ph, ph + 1);
#endif
}
```
